# Optimizing an MI355X kernel written in HIP

```python
import jax, jax.numpy as jnp
from jax import lax
import numpy as np

D_MODEL = 1024
BATCH = 4
SEQ = 8192
DEPTH = 2

CHUNK = 64
RMS_EPS = 1e-5
CONV_DIM = D_MODEL
CONV_WIDTH = 3
HEAD_DIM = 64
N_Q_HEADS = D_MODEL // HEAD_DIM
N_KV_HEADS = 2
GQA_GROUP = N_Q_HEADS // N_KV_HEADS
WINDOW = 128
WINDOW_CHUNKS = WINDOW // CHUNK
ROT_DIM = HEAD_DIM // 4
ROPE_THETA = 500000.0
Q_W = N_Q_HEADS * HEAD_DIM
KV_W = N_KV_HEADS * HEAD_DIM
SPLITS = [CONV_DIM, 2 * CONV_DIM, 3 * CONV_DIM, 3 * CONV_DIM + Q_W, 3 * CONV_DIM + Q_W + KV_W, 3 * CONV_DIM + Q_W + 2 * KV_W]
IN_COLS = 3 * CONV_DIM + Q_W + 2 * KV_W + 2 * D_MODEL
N_GROUPS = 8
EXPERTS_PER_GROUP = 8
N_EXPERTS = N_GROUPS * EXPERTS_PER_GROUP
EXPERT_FF = 512
TOP_K = 2
MOE_BLOCK = 256

kernel_name = 'hybrid_conv_swa_hmoe_block'


def rms_norm(x, g):
    xf = x.astype(jnp.float32)
    y = xf * lax.rsqrt(jnp.mean(xf * xf, axis=-1, keepdims=True) + RMS_EPS)
    return (y * g.astype(jnp.float32)).astype(x.dtype)


def rotary_tables(positions):
    inv = ROPE_THETA ** (-jnp.arange(0, ROT_DIM, 2, dtype=jnp.float32) / ROT_DIM)
    ang = positions.astype(jnp.float32)[..., None] * inv
    return jnp.cos(ang), jnp.sin(ang)


def apply_partial_rotary(t, cos, sin):
    half = ROT_DIM // 2
    r1, r2, rest = t[..., :half], t[..., half:ROT_DIM], t[..., ROT_DIM:]
    c = cos[:, :, None, :].astype(t.dtype)
    s = sin[:, :, None, :].astype(t.dtype)
    return jnp.concatenate([r1 * c - r2 * s, r2 * c + r1 * s, rest], axis=-1)


def short_conv_mixer(cb, cc, cx, conv_w, w_conv_out):
    u = cb * cx
    y = lax.conv_general_dilated(u, conv_w[:, None, :], window_strides=(1,), padding=[(CONV_WIDTH - 1, 0)], dimension_numbers=('NWC', 'WIO', 'NWC'), feature_group_count=CONV_DIM)
    return (cc * y) @ w_conv_out


def sliding_window_sink_attention(q, k, v, sinks):
    b, s = q.shape[0], q.shape[1]
    nc = s // CHUNK
    qc = q.reshape(b, nc, CHUNK, N_KV_HEADS, GQA_GROUP, HEAD_DIM)

    def band(t):
        tc = t.reshape(b, nc, CHUNK, N_KV_HEADS, HEAD_DIM)
        tp = jnp.pad(tc, ((0, 0), (WINDOW_CHUNKS, 0), (0, 0), (0, 0), (0, 0)))
        return jnp.concatenate([tp[:, j:j + nc] for j in range(WINDOW_CHUNKS + 1)], axis=2)

    kb, vb = band(k), band(v)
    scores = jnp.einsum('bcqkgd,bcskd->bckgqs', qc, kb, preferred_element_type=jnp.float32) * (HEAD_DIM ** -0.5)
    key_chunk = jnp.arange(nc)[:, None] - WINDOW_CHUNKS + jnp.arange(WINDOW_CHUNKS + 1)[None, :]
    valid = jnp.repeat(key_chunk >= 0, CHUNK, axis=1)
    scores = jnp.where(valid[None, :, None, None, None, :], scores, -jnp.inf)
    sink = sinks.astype(jnp.float32).reshape(N_KV_HEADS, GQA_GROUP)[None, None, :, :, None, None]
    m = jnp.maximum(jnp.max(scores, axis=-1, keepdims=True), sink)
    p = jnp.exp(scores - m)
    p = p / (jnp.sum(p, axis=-1, keepdims=True) + jnp.exp(sink - m))
    out = jnp.einsum('bckgqs,bcskd->bcqkgd', p.astype(v.dtype), vb)
    return out.reshape(b, s, Q_W)


def mixer_block(h, cos, sin, w_in, b_gate, conv_w, sinks, w_conv_out, w_attn_out, w_o):
    b, s, _ = h.shape
    proj = h @ w_in
    cb, cc, cx, q, k, v, gates = jnp.split(proj, SPLITS, axis=-1)
    conv_out = short_conv_mixer(cb, cc, cx, conv_w, w_conv_out)
    q = apply_partial_rotary(q.reshape(b, s, N_Q_HEADS, HEAD_DIM), cos, sin)
    k = apply_partial_rotary(k.reshape(b, s, N_KV_HEADS, HEAD_DIM), cos, sin)
    v = v.reshape(b, s, N_KV_HEADS, HEAD_DIM)
    attn_out = sliding_window_sink_attention(q, k, v, sinks) @ w_attn_out
    g = jax.nn.sigmoid(gates + b_gate)
    g_conv, g_attn = g[..., :D_MODEL], g[..., D_MODEL:]
    return (g_conv * conv_out + g_attn * attn_out) @ w_o


def hierarchical_moe(h, w_group, b_group, w_route, b_route, w1, w3, w2):
    b, s, d = h.shape
    t = h.reshape(-1, d)
    n_tok = t.shape[0]
    group_logits = (t @ w_group).astype(jnp.float32) + b_group.astype(jnp.float32)
    group_probs = jax.nn.softmax(group_logits, axis=-1)
    g_top = jnp.argmax(group_logits, axis=-1)
    p_group = jnp.take_along_axis(group_probs, g_top[:, None], axis=-1)
    exp_logits = jnp.einsum('td,gde->tge', t, w_route).astype(jnp.float32) + b_route.astype(jnp.float32)
    exp_logits = jnp.take_along_axis(exp_logits, g_top[:, None, None], axis=1)[:, 0]
    top_p, top_e = lax.top_k(jax.nn.softmax(exp_logits, axis=-1), TOP_K)
    top_p = top_p / jnp.sum(top_p, axis=-1, keepdims=True)
    weights = p_group * top_p
    expert_ids = g_top[:, None] * EXPERTS_PER_GROUP + top_e
    n_assign = n_tok * TOP_K
    flat_e = expert_ids.reshape(-1).astype(jnp.int32)
    flat_w = weights.reshape(-1)
    flat_tok = jnp.repeat(jnp.arange(n_tok, dtype=jnp.int32), TOP_K)
    order = jnp.argsort(flat_e)
    se, sw, stok = flat_e[order], flat_w[order], flat_tok[order]
    counts = jnp.bincount(flat_e, length=N_EXPERTS)
    padded = (counts + MOE_BLOCK - 1) // MOE_BLOCK * MOE_BLOCK
    start = jnp.cumsum(counts) - counts
    pad_end = jnp.cumsum(padded)
    pad_start = pad_end - padded
    dest = pad_start[se] + jnp.arange(n_assign) - start[se]
    n_rows = -(-n_assign // MOE_BLOCK) * MOE_BLOCK + N_EXPERTS * MOE_BLOCK
    n_blocks = n_rows // MOE_BLOCK
    row_tok = jnp.zeros((n_rows,), jnp.int32).at[dest].set(stok)
    row_w = jnp.zeros((n_rows,), jnp.float32).at[dest].set(sw)
    block_expert = jnp.minimum(jnp.searchsorted(pad_end, jnp.arange(n_blocks) * MOE_BLOCK, side='right'), N_EXPERTS - 1)
    xs = t[row_tok].reshape(n_blocks, MOE_BLOCK, d)

    def expert_block(args):
        xb, e = args
        hid = jax.nn.silu(xb @ w1[e]) * (xb @ w3[e])
        return hid @ w2[e]

    ys = lax.map(expert_block, (xs, block_expert)).reshape(n_rows, d)
    out = jax.ops.segment_sum(ys * row_w[:, None].astype(ys.dtype), row_tok, num_segments=n_tok)
    return out.reshape(b, s, d)


def setup_inputs(seed: int = 0) -> dict:
    key = jax.random.key(seed)
    ks = jax.random.split(key, 20)
    f32 = jnp.float32

    def nrm(k, shape, scale):
        return jax.random.normal(k, shape, f32) * scale

    x = nrm(ks[0], (BATCH, SEQ, D_MODEL), 1.0)
    offsets = jax.random.randint(ks[1], (BATCH, 1), 0, 64, dtype=jnp.int32) * CHUNK
    positions = offsets + jnp.arange(SEQ, dtype=jnp.int32)[None, :]
    return {
        'x': x,
        'positions': positions,
        'norm1_g': 1.0 + nrm(ks[2], (DEPTH, D_MODEL), 0.02),
        'w_in': nrm(ks[3], (DEPTH, D_MODEL, IN_COLS), D_MODEL ** -0.5),
        'b_gate': nrm(ks[4], (DEPTH, 2 * D_MODEL), 0.02),
        'conv_w': nrm(ks[5], (DEPTH, CONV_WIDTH, CONV_DIM), CONV_WIDTH ** -0.5),
        'sinks': nrm(ks[6], (DEPTH, N_Q_HEADS), 0.5),
        'w_conv_out': nrm(ks[7], (DEPTH, CONV_DIM, D_MODEL), CONV_DIM ** -0.5),
        'w_attn_out': nrm(ks[8], (DEPTH, Q_W, D_MODEL), Q_W ** -0.5),
        'w_o': nrm(ks[9], (DEPTH, D_MODEL, D_MODEL), D_MODEL ** -0.5),
        'norm2_g': 1.0 + nrm(ks[10], (DEPTH, D_MODEL), 0.02),
        'w_group': nrm(ks[11], (DEPTH, D_MODEL, N_GROUPS), D_MODEL ** -0.5),
        'b_group': nrm(ks[12], (DEPTH, N_GROUPS), 0.01),
        'w_route': nrm(ks[13], (DEPTH, N_GROUPS, D_MODEL, EXPERTS_PER_GROUP), D_MODEL ** -0.5),
        'b_route': nrm(ks[14], (DEPTH, N_GROUPS, EXPERTS_PER_GROUP), 0.01),
        'w1': nrm(ks[15], (DEPTH, N_EXPERTS, D_MODEL, EXPERT_FF), D_MODEL ** -0.5),
        'w3': nrm(ks[16], (DEPTH, N_EXPERTS, D_MODEL, EXPERT_FF), D_MODEL ** -0.5),
        'w2': nrm(ks[17], (DEPTH, N_EXPERTS, EXPERT_FF, D_MODEL), EXPERT_FF ** -0.5),
        'final_g': 1.0 + nrm(ks[18], (D_MODEL,), 0.02),
    }


def reference(x, positions, norm1_g, w_in, b_gate, conv_w, sinks, w_conv_out, w_attn_out, w_o, norm2_g, w_group, b_group, w_route, b_route, w1, w3, w2, final_g):
    cos, sin = rotary_tables(positions)
    h = x
    for l in range(DEPTH):
        h = h + mixer_block(rms_norm(h, norm1_g[l]), cos, sin, w_in[l], b_gate[l], conv_w[l], sinks[l], w_conv_out[l], w_attn_out[l], w_o[l])
        h = h + hierarchical_moe(rms_norm(h, norm2_g[l]), w_group[l], b_group[l], w_route[l], b_route[l], w1[l], w3[l], w2[l])
    return rms_norm(h, final_g)
```

```cpp
#include <hip/hip_runtime.h>
#include <cstdio>
#include <cstdint>

#ifndef MK_PER_PHASE
#define MK_PER_PHASE 0
#endif

constexpr int BATCH = 4, SEQ = 8192, D = 1024, T = BATCH * SEQ, DEPTH = 2;
constexpr int IN_COLS = 6400, NKV = 2, HD = 64, CHUNK = 64;
constexpr int NEXP = 64, FF = 512;
constexpr float RMS_EPS = 1e-5f;
constexpr float C2 = 0.125f * 1.4426950408889634f;
constexpr float LOG2E = 1.4426950408889634f;
constexpr int LIST_CAP = T;
constexpr int MAX_UNITS = 6;

namespace pg8 {
#define PG8_LAS __attribute__((address_space(3)))
typedef unsigned short bf16_t;
typedef short bf16x8 __attribute__((ext_vector_type(8)));
typedef float f32x4 __attribute__((ext_vector_type(4)));
typedef unsigned u32x4 __attribute__((ext_vector_type(4)));
typedef unsigned u32x2 __attribute__((ext_vector_type(2)));
typedef int v4i32 __attribute__((ext_vector_type(4)));
constexpr int BM = 256, BK = 64, HALF = 128, HTB = HALF * BK * 2, STAGE_BYTES = 8 * HTB, NXCD = 8, WGM = 8;

__host__ __device__ __forceinline__ int lds_byte(int r, int c) { const int st = (r >> 4) * 2 + (c >> 5), rr = r & 15, cc = c & 31, ob = rr * 64 + cc * 2; return st * 1024 + (ob ^ (((ob >> 9) & 1) << 5)); }
__host__ __device__ __forceinline__ void stage_rc(int b, int& R, int& C) { const int st = b / 1024, sb = b % 1024, swz = sb ^ (((sb >> 9) & 1) << 5); R = (st >> 1) * 16 + swz / 64; C = (st & 1) * 32 + (swz % 64) / 2; }
__host__ __device__ __forceinline__ int perm32(int rho) { const int n = rho >> 4, i = rho & 15; return 8 * (i >> 2) + 4 * n + (i & 3); }

__device__ __forceinline__ int lane_volatile() { int l; asm volatile("v_mbcnt_lo_u32_b32 %0, -1, 0\n\tv_mbcnt_hi_u32_b32 %0, -1, %0" : "=v"(l)); return l; }
struct Unit { int pm, pn; };
struct Gemm { const bf16_t* A; const bf16_t* Bt; const bf16_t* A2; };

template <int M_, int N_> struct StaticOrder {
    static constexpr int nM = M_ / BM, nN = N_ / BM, nwg = nM * nN; int G, c;
    __host__ __device__ void init(int G_, int c_) { G = G_; c = c_; }
    __host__ __device__ bool next(int i, Unit& u) const {
        const long L = (long)i * G + c; if (L >= nwg) return false;
        int wgid = (int)L; { const int q = nwg / NXCD, r = nwg % NXCD, xcd = wgid % NXCD, off = wgid / NXCD; wgid = (xcd < r ? xcd * (q + 1) : r * (q + 1) + (xcd - r) * q) + off; }
        const int nig = WGM * nN, gid = wgid / nig, fm = gid * WGM, gsz = (nM - fm) < WGM ? (nM - fm) : WGM;
        u.pm = fm + ((wgid % nig) % gsz); u.pn = (wgid % nig) / gsz; return true;
    }
};
struct MoeOrder {
    int NT4, G, c; const PG8_LAS int* uexp;
    __device__ __forceinline__ bool next(int i, Unit& u) const {
        const int L = i * G + c; if (L >= NT4) return false;
        u.pm = L >> 2; u.pn = __builtin_amdgcn_readfirstlane(uexp[i]) * 4 + (L & 3); return true;
    }
};

typedef float f32x2_t __attribute__((ext_vector_type(2))); typedef __bf16 bf16x2_t __attribute__((ext_vector_type(2)));
__device__ __forceinline__ unsigned cvt_pk_bf16(float lo, float hi) { unsigned r; asm volatile("s_nop 0\n\tv_cvt_pk_bf16_f32 %0, %1, %2" : "=v"(r) : "v"(lo), "v"(hi)); return r; }
__device__ __forceinline__ unsigned cvt_pk_bf16_c(float lo, float hi) { f32x2_t v = {lo, hi}; bf16x2_t b = __builtin_convertvector(v, bf16x2_t); return __builtin_bit_cast(unsigned, b); }
__device__ __forceinline__ float bf_lo(unsigned w) { return __uint_as_float(w << 16); }
__device__ __forceinline__ float bf_hi(unsigned w) { return __uint_as_float(w & 0xffff0000u); }
__device__ __forceinline__ u32x2 pack8_f8(const f32x4 a, const f32x4 b) { int w0 = __builtin_bit_cast(int, a[0]), w1 = __builtin_bit_cast(int, b[0]);
    w0 = __builtin_amdgcn_cvt_pk_fp8_f32(a[0], a[1], w0, false); w0 = __builtin_amdgcn_cvt_pk_fp8_f32(a[2], a[3], w0, true);
    w1 = __builtin_amdgcn_cvt_pk_fp8_f32(b[0], b[1], w1, false); w1 = __builtin_amdgcn_cvt_pk_fp8_f32(b[2], b[3], w1, true);
    u32x2 r; r.x = (unsigned)w0; r.y = (unsigned)w1; return r; }
constexpr float W13_SCALE = 32.0f, W2_SCALE = 16.0f, SLAB_SCALE = 16.0f, WA_SCALE = 32.0f, WIN8_SCALE = 32.0f, Q8_SCALE = 8.0f;
__device__ __forceinline__ u32x4 pack8c(const f32x4 a, const f32x4 b) { u32x4 w; w.x = cvt_pk_bf16_c(a[0], a[1]); w.y = cvt_pk_bf16_c(a[2], a[3]); w.z = cvt_pk_bf16_c(b[0], b[1]); w.w = cvt_pk_bf16_c(b[2], b[3]); return w; }
__device__ __forceinline__ u32x4 pack8(const f32x4 a, const f32x4 b) { u32x4 w; w.x = cvt_pk_bf16(a[0], a[1]); w.y = cvt_pk_bf16(a[2], a[3]); w.z = cvt_pk_bf16(b[0], b[1]); w.w = cvt_pk_bf16(b[2], b[3]); return w; }

typedef unsigned bu32x4_t __attribute__((__vector_size__(16))); typedef unsigned bu32x2_t __attribute__((__vector_size__(8)));
typedef f32x4 Acc[2][2][4][2];
__device__ __forceinline__ f32x4 zero4_asm() { float a, b, c, d; asm volatile("v_mov_b32 %0, 0\n\tv_mov_b32 %1, 0\n\tv_mov_b32 %2, 0\n\tv_mov_b32 %3, 0" : "=v"(a), "=v"(b), "=v"(c), "=v"(d)); return (f32x4){a, b, c, d}; }

template <int MODE> struct EpiInProj {
    bf16_t *U, *CC, *Q, *Kb, *VT, *G; const float* bgate; const float* cs; float sc;
    __device__ __forceinline__ void operator()(const Acc& acc, const Unit& u, int ui, int wr, int wc, int fr, int fq) const {
        const int pn = MODE ? 12 + u.pn : u.pn; const int row0 = u.pm * BM + wr * 64 + fr; const int cw = wc * 32 + 8 * fq;
        if (MODE == 0 && pn < 8) {
#pragma unroll
            for (int ai = 0; ai < 2; ++ai)
#pragma unroll
                for (int m = 0; m < 4; ++m) { const size_t row = row0 + ai * HALF + m * 16;
                    *(u32x4*)(U + row * D + pn * 128 + cw) = pack8(acc[ai][0][m][0] * acc[ai][1][m][0], acc[ai][0][m][1] * acc[ai][1][m][1]); }
        } else if (MODE == 0) {
#pragma unroll
            for (int ai = 0; ai < 2; ++ai)
#pragma unroll
                for (int m = 0; m < 4; ++m) { const size_t row = row0 + ai * HALF + m * 16;
#pragma unroll
                    for (int bj = 0; bj < 2; ++bj) *(u32x4*)(CC + row * D + (pn - 8) * 256 + bj * HALF + cw) = pack8c(acc[ai][bj][m][0], acc[ai][bj][m][1]); }
        } else if (pn < 16) {
            const bool rot = ((wc & 1) == 0) && (fq < 2);
#pragma unroll
            for (int ai = 0; ai < 2; ++ai) {
                f32x4 cv[4], sv[4];
#pragma unroll
                for (int m = 0; m < 4; ++m) { cv[m] = (f32x4){1.f, 1.f, 1.f, 1.f}; sv[m] = (f32x4){0.f, 0.f, 0.f, 0.f}; }
                if (rot) {
#pragma unroll
                    for (int m = 0; m < 4; ++m) { const size_t row = row0 + ai * HALF + m * 16; cv[m] = *(const f32x4*)(cs + row * 16 + 4 * fq); sv[m] = *(const f32x4*)(cs + row * 16 + 8 + 4 * fq); } }
#pragma unroll
                for (int m = 0; m < 4; ++m) { const size_t row = row0 + ai * HALF + m * 16;
                    const f32x4 c4 = cv[m], s4 = sv[m];
#pragma unroll
                    for (int bj = 0; bj < 2; ++bj) { f32x4 a = acc[ai][bj][m][0] * sc, b = acc[ai][bj][m][1] * sc;
                        f32x4 ra = {a[0] * c4[0] - a[1] * s4[0], a[1] * c4[0] + a[0] * s4[0], a[2] * c4[1] - a[3] * s4[1], a[3] * c4[1] + a[2] * s4[1]};
                        f32x4 rb = {b[0] * c4[2] - b[1] * s4[2], b[1] * c4[2] + b[0] * s4[2], b[2] * c4[3] - b[3] * s4[3], b[3] * c4[3] + b[2] * s4[3]};
                        *(u32x2*)((unsigned char*)Q + row * D + (pn - 12) * 256 + bj * HALF + cw) = pack8_f8(ra * (C2 * Q8_SCALE), rb * (C2 * Q8_SCALE)); }
                    asm volatile("" ::: "memory"); __builtin_amdgcn_sched_barrier(0); } }
        } else if (pn == 16) {
            const bool rot = ((wc & 1) == 0) && (fq < 2);
#pragma unroll
            for (int ai = 0; ai < 2; ++ai) {
                f32x4 cv[4], sv[4];
#pragma unroll
                for (int m = 0; m < 4; ++m) { cv[m] = (f32x4){1.f, 1.f, 1.f, 1.f}; sv[m] = (f32x4){0.f, 0.f, 0.f, 0.f}; }
                if (rot) {
#pragma unroll
                    for (int m = 0; m < 4; ++m) { const size_t row = row0 + ai * HALF + m * 16; cv[m] = *(const f32x4*)(cs + row * 16 + 4 * fq); sv[m] = *(const f32x4*)(cs + row * 16 + 8 + 4 * fq); } }
#pragma unroll
                for (int m = 0; m < 4; ++m) { const size_t row = row0 + ai * HALF + m * 16;
                    const f32x4 c4 = cv[m], s4 = sv[m];
                    { f32x4 a = acc[ai][0][m][0] * sc, b = acc[ai][0][m][1] * sc;
                      f32x4 ra = {a[0] * c4[0] - a[1] * s4[0], a[1] * c4[0] + a[0] * s4[0], a[2] * c4[1] - a[3] * s4[1], a[3] * c4[1] + a[2] * s4[1]};
                      f32x4 rb = {b[0] * c4[2] - b[1] * s4[2], b[1] * c4[2] + b[0] * s4[2], b[2] * c4[3] - b[3] * s4[3], b[3] * c4[3] + b[2] * s4[3]};
                      *(u32x4*)(Kb + row * 128 + cw) = pack8(ra, rb); }
                    { const int b_ = (int)(row >> 13), s_ = (int)(row & 8191); const int kh = wc >> 1, d0 = 32 * (wc & 1) + 8 * fq;
                      bf16_t* vp = VT + ((size_t)((b_ * 2 + kh) * 64 + d0)) * SEQ + s_;
#pragma unroll
                      for (int n = 0; n < 2; ++n)
#pragma unroll
                          for (int j = 0; j < 4; ++j) { const unsigned w = cvt_pk_bf16_c(acc[ai][1][m][n][j] * sc, 0.f); vp[(size_t)(4 * n + j) * SEQ] = (bf16_t)(w & 0xffffu); } } } }
        } else {
            const int gc0 = (pn - 17) * 256 + cw;
            f32x4 bv[2][2];
#pragma unroll
            for (int bj = 0; bj < 2; ++bj)
#pragma unroll
                for (int n = 0; n < 2; ++n) bv[bj][n] = *(const f32x4*)(bgate + gc0 + bj * HALF + 4 * n);
#pragma unroll
            for (int ai = 0; ai < 2; ++ai)
#pragma unroll
                for (int m = 0; m < 4; ++m) { const size_t row = row0 + ai * HALF + m * 16;
#pragma unroll
                    for (int bj = 0; bj < 2; ++bj) { f32x4 v[2];
#pragma unroll
                        for (int n = 0; n < 2; ++n) { const f32x4 x = acc[ai][bj][m][n] * sc + bv[bj][n];
#pragma unroll
                            for (int j = 0; j < 4; ++j) v[n][j] = __builtin_rintf(255.0f * __builtin_amdgcn_rcpf(1.0f + __builtin_amdgcn_exp2f(-LOG2E * x[j]))); }
                        u32x2 w; w.x = 0u; w.y = 0u;
#pragma unroll
                        for (int j = 0; j < 4; ++j) { w.x = __builtin_amdgcn_cvt_pk_u8_f32(v[0][j], j, w.x); w.y = __builtin_amdgcn_cvt_pk_u8_f32(v[1][j], j, w.y); }
                        *(u32x2*)((unsigned char*)G + row * 2048 + gc0 + bj * HALF) = w; } }
        }
    }
};
template <bool ADD> struct EpiGate {
    const bf16_t* G; int gcol0; const bf16_t* addend; bf16_t* O;
    __device__ __forceinline__ void operator()(const Acc& acc, const Unit& u, int ui, int wr, int wc, int fr, int fq) const {
        const int row0 = u.pm * BM + wr * 64 + fr; const int col0 = u.pn * BM + wc * 32 + 8 * fq;
#pragma unroll
        for (int ai = 0; ai < 2; ++ai) {
            u32x2 gv[4][2]; u32x4 tv[4][2];
#pragma unroll
            for (int m = 0; m < 4; ++m)
#pragma unroll
                for (int bj = 0; bj < 2; ++bj) { const size_t row = row0 + ai * HALF + m * 16; const int col = col0 + bj * HALF;
                    gv[m][bj] = *(const u32x2*)((const unsigned char*)G + row * 2048 + gcol0 + col);
                    if (ADD) tv[m][bj] = *(const u32x4*)(addend + row * D + col); }
#pragma unroll
            for (int m = 0; m < 4; ++m)
#pragma unroll
                for (int bj = 0; bj < 2; ++bj) { const size_t row = row0 + ai * HALF + m * 16; const int col = col0 + bj * HALF;
                    const u32x2 g = gv[m][bj]; constexpr float Q = 1.0f / 255.0f;
                    f32x4 a = acc[ai][bj][m][0], b = acc[ai][bj][m][1];
                    a = a * ((f32x4){(float)(g.x & 0xffu), (float)((g.x >> 8) & 0xffu), (float)((g.x >> 16) & 0xffu), (float)(g.x >> 24)} * Q);
                    b = b * ((f32x4){(float)(g.y & 0xffu), (float)((g.y >> 8) & 0xffu), (float)((g.y >> 16) & 0xffu), (float)(g.y >> 24)} * Q);
                    if (ADD) { const u32x4 t = tv[m][bj];
                        a = a + (f32x4){bf_lo(t.x), bf_hi(t.x), bf_lo(t.y), bf_hi(t.y)}; b = b + (f32x4){bf_lo(t.z), bf_hi(t.z), bf_lo(t.w), bf_hi(t.w)}; }
                    *(u32x4*)(O + row * D + col) = pack8(a, b); }
        }
    }
};
struct EpiGate2 {
    const unsigned char* G8; bf16_t* O;
    __device__ __forceinline__ void mid(Acc& acc, const Unit& u, int wr, int wc, int fr, int fq) const {
        const auto rG = __builtin_amdgcn_make_buffer_rsrc((void*)G8, 0, 0xffffffff, 0x00020000);
        int vo = (u.pm * BM + wr * 64 + fr) * 2048 + u.pn * BM + wc * 32 + 8 * fq;
        asm volatile("" : "+v"(vo) :: "memory");
#pragma unroll
        for (int ai = 0; ai < 2; ++ai) {
            u32x2 gc[4][2], ga[4][2];
#pragma unroll
            for (int m = 0; m < 4; ++m)
#pragma unroll
                for (int bj = 0; bj < 2; ++bj) {
                    gc[m][bj] = __builtin_bit_cast(u32x2, __builtin_amdgcn_raw_buffer_load_b64(rG, vo + bj * HALF, (ai * HALF + m * 16) * 2048, 0));
                    ga[m][bj] = __builtin_bit_cast(u32x2, __builtin_amdgcn_raw_buffer_load_b64(rG, vo + bj * HALF + 1024, (ai * HALF + m * 16) * 2048, 0)); }
#pragma unroll
            for (int m = 0; m < 4; ++m)
#pragma unroll
                for (int bj = 0; bj < 2; ++bj)
#pragma unroll
                    for (int n = 0; n < 2; ++n) { const unsigned c = n ? gc[m][bj].y : gc[m][bj].x, a = n ? ga[m][bj].y : ga[m][bj].x;
#pragma unroll
                        for (int j = 0; j < 4; ++j) { const float qc = (float)((c >> (8 * j)) & 0xffu), qa = fmaxf((float)((a >> (8 * j)) & 0xffu), 1.0f);
                            acc[ai][bj][m][n][j] *= (WA_SCALE * qc) * __builtin_amdgcn_rcpf(qa); } }
            asm volatile("" ::: "memory"); __builtin_amdgcn_sched_barrier(0);
        }
    }
    __device__ __forceinline__ void operator()(const Acc& acc, const Unit& u, int ui, int wr, int wc, int fr, int fq) const {
        const auto rG = __builtin_amdgcn_make_buffer_rsrc((void*)G8, 0, 0xffffffff, 0x00020000);
        int row0 = u.pm * BM + wr * 64 + fr; const int col0 = u.pn * BM + wc * 32 + 8 * fq;
        asm volatile("" : "+v"(row0));
        const int vo = row0 * 2048 + col0 + 1024;
        u32x2 ga[2][4][2];
#pragma unroll
        for (int ai = 0; ai < 2; ++ai)
#pragma unroll
            for (int m = 0; m < 4; ++m)
#pragma unroll
                for (int bj = 0; bj < 2; ++bj) ga[ai][m][bj] = __builtin_bit_cast(u32x2, __builtin_amdgcn_raw_buffer_load_b64(rG, vo + bj * HALF, (ai * HALF + m * 16) * 2048, 0));
#pragma unroll
        for (int ai = 0; ai < 2; ++ai)
#pragma unroll
            for (int m = 0; m < 4; ++m)
#pragma unroll
                for (int bj = 0; bj < 2; ++bj) { const u32x2 g = ga[ai][m][bj]; constexpr float Q = 1.0f / (255.0f * WA_SCALE); f32x4 v[2];
#pragma unroll
                    for (int n = 0; n < 2; ++n) { const unsigned a = n ? g.y : g.x;
#pragma unroll
                        for (int j = 0; j < 4; ++j) v[n][j] = acc[ai][bj][m][n][j] * (fmaxf((float)((a >> (8 * j)) & 0xffu), 1.0f) * Q); }
                    *(u32x4*)(O + (size_t)(row0 + ai * HALF + m * 16) * D + col0 + bj * HALF) = pack8(v[0], v[1]); }
    }
};
struct EpiResid {
    const float* Xin; const bf16_t* Hin16; bf16_t* Hout; unsigned char* H8; const float* g2;
    __device__ __forceinline__ void operator()(const Acc& acc, const Unit& u, int ui, int wr, int wc, int fr, int fq) const {
        const int row0 = u.pm * BM + wr * 64 + fr; const int col0 = u.pn * BM + wc * 32 + 8 * fq;
        f32x4 gv[2][2];
#pragma unroll
        for (int bj = 0; bj < 2; ++bj) { gv[bj][0] = *(const f32x4*)(g2 + col0 + bj * HALF); gv[bj][1] = *(const f32x4*)(g2 + col0 + bj * HALF + 4); }
        if (Xin) {
#pragma unroll
            for (int ai = 0; ai < 2; ++ai)
#pragma unroll
                for (int mh = 0; mh < 2; ++mh) {
                    f32x4 hv[2][2][2];
#pragma unroll
                    for (int mm = 0; mm < 2; ++mm)
#pragma unroll
                        for (int bj = 0; bj < 2; ++bj) { const size_t o = (size_t)(row0 + ai * HALF + (2 * mh + mm) * 16) * D + col0 + bj * HALF;
                            hv[mm][bj][0] = *(const f32x4*)(Xin + o); hv[mm][bj][1] = *(const f32x4*)(Xin + o + 4); }
#pragma unroll
                    for (int mm = 0; mm < 2; ++mm)
#pragma unroll
                        for (int bj = 0; bj < 2; ++bj) { const int m = 2 * mh + mm; const size_t o = (size_t)(row0 + ai * HALF + m * 16) * D + col0 + bj * HALF;
                            const f32x4 r0 = hv[mm][bj][0] + acc[ai][bj][m][0], r1 = hv[mm][bj][1] + acc[ai][bj][m][1];
                            *(u32x4*)(Hout + o) = pack8(r0, r1); *(u32x2*)(H8 + o) = pack8_f8(r0 * gv[bj][0], r1 * gv[bj][1]); }
                }
        } else {
#pragma unroll
            for (int ai = 0; ai < 2; ++ai) {
                u32x4 hv[4][2];
#pragma unroll
                for (int m = 0; m < 4; ++m)
#pragma unroll
                    for (int bj = 0; bj < 2; ++bj) hv[m][bj] = *(const u32x4*)(Hin16 + (size_t)(row0 + ai * HALF + m * 16) * D + col0 + bj * HALF);
#pragma unroll
                for (int m = 0; m < 4; ++m)
#pragma unroll
                    for (int bj = 0; bj < 2; ++bj) { const size_t o = (size_t)(row0 + ai * HALF + m * 16) * D + col0 + bj * HALF; const u32x4 t = hv[m][bj];
                        const f32x4 r0 = (f32x4){bf_lo(t.x), bf_hi(t.x), bf_lo(t.y), bf_hi(t.y)} + acc[ai][bj][m][0], r1 = (f32x4){bf_lo(t.z), bf_hi(t.z), bf_lo(t.w), bf_hi(t.w)} + acc[ai][bj][m][1];
                        *(u32x4*)(Hout + o) = pack8(r0, r1); *(u32x2*)(H8 + o) = pack8_f8(r0 * gv[bj][0], r1 * gv[bj][1]); }
            }
        }
    }
};
struct EpiFfn1 {
    unsigned char* HID8; const PG8_LAS float* rs;
    __device__ __forceinline__ void operator()(const Acc& acc, const Unit& u, int ui, int wr, int wc, int fr, int fq) const {
        const int row0 = u.pm * BM + wr * 64 + fr; const int col0 = (u.pn & 3) * 128 + wc * 32 + 8 * fq;
#pragma unroll
        for (int ai = 0; ai < 2; ++ai)
#pragma unroll
            for (int m = 0; m < 4; ++m) { const size_t row = row0 + ai * HALF + m * 16; f32x4 v[2]; const float r = rs[ui * 256 + ai * HALF + wr * 64 + m * 16 + fr] * (1.0f / W13_SCALE);
#pragma unroll
                for (int n = 0; n < 2; ++n)
#pragma unroll
                    for (int j = 0; j < 4; ++j) { const float x = acc[ai][0][m][n][j] * r; v[n][j] = x * __builtin_amdgcn_rcpf(1.0f + __builtin_amdgcn_exp2f(-LOG2E * x)) * (acc[ai][1][m][n][j] * r); }
                *(u32x2*)(HID8 + row * FF + col0) = pack8_f8(v[0], v[1]); }
    }
};
struct EpiFfn2 {
    unsigned char* SLAB; const PG8_LAS int* aid; const PG8_LAS float* wt;
    __device__ __forceinline__ void operator()(const Acc& acc, const Unit& u, int ui, int wr, int wc, int fr, int fq) const {
        const int col0 = (u.pn & 3) * BM + wc * 32 + 8 * fq;
#pragma unroll
        for (int ai = 0; ai < 2; ++ai)
#pragma unroll
            for (int m = 0; m < 4; ++m) { const int rl = ai * HALF + wr * 64 + m * 16 + fr; const int a = aid[ui * 256 + rl]; const float w = wt[ui * 256 + rl] * (SLAB_SCALE / W2_SCALE);
                if (a >= 0) {
#pragma unroll
                    for (int bj = 0; bj < 2; ++bj) *(u32x2*)(SLAB + (size_t)a * D + col0 + bj * HALF) = pack8_f8(acc[ai][bj][m][0] * w, acc[ai][bj][m][1] * w); } }
    }
};

template <class Epi, class Sched, bool ALIGN_EPI, bool SP2, bool GATHER, int KDIM, bool DUALA = false, bool F8 = false, bool MIXED = false>
__device__ __forceinline__ void gemm_phase(PG8_LAS unsigned char* lds, const int tid, const Gemm g, const Sched& S, const Epi& E, const PG8_LAS int* tokTab) {
    static_assert(SP2 && (!MIXED || (DUALA && !F8 && !GATHER)), "two super-phases per K-tile; MIXED needs DUALA");
    const int wid = __builtin_amdgcn_readfirstlane(tid >> 6), lane = tid & 63, wr = wid >> 2, wc = wid & 3, fr = lane & 15, fq = lane >> 4;
    constexpr int ESZ = F8 ? 1 : 2, K = KDIM, NTB = 16, nt = MIXED ? 24 : K * ESZ / 128, MIDT = MIXED ? NTB : nt / 2;
    constexpr unsigned AROW = MIXED ? 2048u : (unsigned)((DUALA ? K / 2 : K) * ESZ), AROWF = 1024u, BROW = MIXED ? 3072u : (unsigned)(K * ESZ);
    unsigned voffA[2], voffAF[2], voffB[2];
#pragma unroll
    for (int i = 0; i < 2; ++i) { int R, C; stage_rc(tid * 16 + i * 8192, R, C); const int Rb = (R & ~31) + perm32(R & 31);
        voffA[i] = (unsigned)R * AROW + (unsigned)(C * 2); voffAF[i] = (unsigned)R * AROWF + (unsigned)(C * 2); voffB[i] = (unsigned)Rb * BROW + (unsigned)(C * 2); }
    constexpr unsigned kstep = (unsigned)(BK * 2);
    constexpr unsigned hstep = (unsigned)HALF * BROW, tstep = 2 * hstep;
    constexpr unsigned hstepA = (unsigned)HALF * AROW, tstepA = 2 * hstepA, hstepAF = (unsigned)HALF * AROWF, tstepAF = 2 * hstepAF;
    const unsigned ldsw = (unsigned)wid * 1024u;
    const int aoffB = lds_byte(wr * 64 + fr, fq * 8), boffB = lds_byte(wc * 32 + fr, fq * 8);
    const int aoffF = lds_byte(wr * 64 + fr, (fq & 1) * 16) + (fq >> 1) * 1024, boffF = lds_byte(wc * 32 + fr, (fq & 1) * 16) + (fq >> 1) * 1024;
    unsigned gA[2][2];
    const auto rA = __builtin_amdgcn_make_buffer_rsrc((void*)g.A, 0, 0xffffffff, 0x00020000);
    const auto rB = __builtin_amdgcn_make_buffer_rsrc((void*)g.Bt, 0, 0xffffffff, 0x00020000);
    const unsigned dA2 = DUALA ? (unsigned)((const char*)g.A2 - (const char*)g.A) : 0u;
#define PG8_SA(b, h) (((b) * 2 + (h)) * HTB)
#define PG8_SB(b, h) ((4 + (b) * 2 + (h)) * HTB)
#define PG8_DMA(rsrc, vo, so, ldsoff) __builtin_amdgcn_raw_ptr_buffer_load_lds(rsrc, (PG8_LAS unsigned*)(lds + (ldsoff)), 16, (vo), (so), 0, 0)
#define PG8_STAGE_B(bufoff, so) do { _Pragma("unroll") for (int _i = 0; _i < 2; ++_i) PG8_DMA(rB, voffB[_i], (so), (bufoff) + ldsw + _i * 8192); } while (0)
#define PG8_STAGE_A(bufoff, so, h, isf) do { _Pragma("unroll") for (int _i = 0; _i < 2; ++_i) { \
        if constexpr (GATHER) PG8_DMA(rA, gA[h][_i], (so), (bufoff) + ldsw + _i * 8192); \
        else if constexpr (MIXED) PG8_DMA(rA, (isf) ? voffAF[_i] : voffA[_i], (so) + (h) * ((isf) ? hstepAF : hstepA), (bufoff) + ldsw + _i * 8192); \
        else PG8_DMA(rA, voffA[_i], (so) + (h) * hstepA, (bufoff) + ldsw + _i * 8192); } } while (0)
#define PG8_LDA(dst, b, h, FX) do { _Pragma("unroll") for (int m = 0; m < 4; ++m) _Pragma("unroll") for (int k = 0; k < 2; ++k) dst[m][k] = *(const PG8_LAS bf16x8*)(lds + PG8_SA(b, h) + ((FX) ? aoffF : aoffB) + m * 2048 + k * ((FX) ? 16 : 1024)); } while (0)
#define PG8_LDB(dst, b, h, FX) do { _Pragma("unroll") for (int n = 0; n < 2; ++n) _Pragma("unroll") for (int k = 0; k < 2; ++k) dst[n][k] = *(const PG8_LAS bf16x8*)(lds + PG8_SB(b, h) + ((FX) ? boffF : boffB) + n * 2048 + k * ((FX) ? 16 : 1024)); } while (0)
#define PG8_F8OP(x) __builtin_shufflevector(__builtin_bit_cast(v4i32, x[0]), __builtin_bit_cast(v4i32, x[1]), 0, 1, 2, 3, 4, 5, 6, 7)
#define PG8_MMA(ai, bj, At, Bt, FX) do { __builtin_amdgcn_s_setprio(1); _Pragma("unroll") for (int m = 0; m < 4; ++m) _Pragma("unroll") for (int n = 0; n < 2; ++n) { \
        if constexpr (FX) acc[ai][bj][m][n] = __builtin_amdgcn_mfma_scale_f32_16x16x128_f8f6f4(PG8_F8OP(Bt[n]), PG8_F8OP(At[m]), acc[ai][bj][m][n], 0, 0, 0, 0x7f7f7f7f, 0, 0x7f7f7f7f); \
        else { _Pragma("unroll") for (int k = 0; k < 2; ++k) acc[ai][bj][m][n] = __builtin_amdgcn_mfma_f32_16x16x32_bf16(Bt[n][k], At[m][k], acc[ai][bj][m][n], 0, 0, 0); } } \
        __builtin_amdgcn_s_setprio(0); } while (0)
#define PG8_WAIT_V(n) asm volatile("s_waitcnt vmcnt(" #n ")" ::: "memory")
#define PG8_WAIT_L(n) asm volatile("s_waitcnt lgkmcnt(" #n ")" ::: "memory")
#define PG8_BAR __builtin_amdgcn_s_barrier()
#define PG8_SCHED __builtin_amdgcn_sched_barrier(0)
#define PG8_GLOAD(dst, ui_) do { int _R, _C; stage_rc(tid * 16, _R, _C); _Pragma("unroll") for (int _h = 0; _h < 2; ++_h) _Pragma("unroll") for (int _i = 0; _i < 2; ++_i) \
        dst[_h][_i] = (unsigned)tokTab[(ui_) * 256 + _h * HALF + _R + 64 * _i] * (unsigned)(K * ESZ) + (unsigned)(_C * 2); } while (0)
    Unit cur, nxt; int ui = 0;
    if (!S.next(0, cur)) return;
    f32x4 acc[2][2][4][2];
#pragma unroll
    for (int a = 0; a < 2; ++a)
#pragma unroll
        for (int b = 0; b < 2; ++b)
#pragma unroll
            for (int m = 0; m < 4; ++m)
#pragma unroll
                for (int n = 0; n < 2; ++n) { acc[a][b][m][n] = zero4_asm(); }
    bf16x8 At[4][2], B0[2][2], B1[2][2];
    unsigned cA = GATHER ? 0u : (unsigned)cur.pm * tstepA, cB = (unsigned)cur.pn * tstep;
    unsigned cA2 = DUALA ? dA2 + (unsigned)cur.pm * (MIXED ? tstepAF : tstepA) : 0u;
#define PG8_AOFF(kt) ((DUALA && (kt) >= MIDT) ? cA2 + (unsigned)((kt) - MIDT) * kstep : cA + (unsigned)(kt) * kstep)
    if constexpr (GATHER) { PG8_GLOAD(gA, 0); }
    PG8_STAGE_B(PG8_SB(0, 0), cB); PG8_STAGE_B(PG8_SB(0, 1), cB + hstep); PG8_STAGE_A(PG8_SA(0, 0), cA, 0, false); PG8_STAGE_A(PG8_SA(0, 1), cA, 1, false);
    if (wr == 1) PG8_BAR;
    PG8_WAIT_V(2); PG8_BAR;
    PG8_STAGE_B(PG8_SB(1, 0), cB + kstep); PG8_STAGE_A(PG8_SA(1, 0), cA + kstep, 0, false); PG8_STAGE_B(PG8_SB(1, 1), cB + hstep + kstep);
    PG8_WAIT_V(6); PG8_BAR;
    for (;;) {
        const bool has_next = S.next(ui + 1, nxt);
        const unsigned nA = GATHER ? 0u : (has_next ? (unsigned)nxt.pm * tstepA : cA), nB = has_next ? (unsigned)nxt.pn * tstep : cB;
        const unsigned nA2 = DUALA ? (has_next ? dA2 + (unsigned)nxt.pm * (MIXED ? tstepAF : tstepA) : cA2) : 0u;
#define PG8_TRIP(FX) do { \
            PG8_LDB(B0, 0, 0, FX); PG8_LDB(B1, 0, 1, FX); PG8_SCHED; PG8_LDA(At, 0, 0, FX); PG8_STAGE_A(PG8_SA(1, 1), a1, 1, f1); \
            if constexpr (GATHER) { if (last && has_next) { PG8_GLOAD(gA, ui + 1); } } \
            PG8_WAIT_V(8); PG8_WAIT_L(0); PG8_BAR; PG8_MMA(0, 0, At, B0, FX); PG8_MMA(0, 1, At, B1, FX); PG8_BAR; PG8_SCHED; \
            PG8_LDA(At, 0, 1, FX); PG8_STAGE_B(PG8_SB(0, 0), b2); PG8_STAGE_B(PG8_SB(0, 1), b2 + hstep); PG8_STAGE_A(PG8_SA(0, 0), a2, 0, f2); \
            PG8_WAIT_V(8); PG8_WAIT_L(0); PG8_BAR; PG8_MMA(1, 0, At, B0, FX); PG8_MMA(1, 1, At, B1, FX); PG8_BAR; PG8_SCHED; \
            PG8_LDB(B0, 1, 0, FX); PG8_LDB(B1, 1, 1, FX); PG8_SCHED; PG8_LDA(At, 1, 0, FX); PG8_STAGE_A(PG8_SA(0, 1), a2, 1, f2); \
            PG8_WAIT_V(8); PG8_WAIT_L(0); PG8_BAR; PG8_MMA(0, 0, At, B0, FX); PG8_MMA(0, 1, At, B1, FX); PG8_BAR; PG8_SCHED; \
            PG8_LDA(At, 1, 1, FX); PG8_STAGE_B(PG8_SB(1, 0), b3); PG8_STAGE_B(PG8_SB(1, 1), b3 + hstep); PG8_STAGE_A(PG8_SA(1, 0), a3, 0, f2); \
            PG8_WAIT_V(8); PG8_WAIT_L(0); PG8_BAR; PG8_MMA(1, 0, At, B0, FX); PG8_MMA(1, 1, At, B1, FX); PG8_BAR; PG8_SCHED; } while (0)
#define PG8_TRIP_VARS() \
            const bool last = (t == nt - 2); \
            const unsigned a1 = PG8_AOFF(t + 1); \
            const unsigned a2 = last ? nA : PG8_AOFF(t + 2), b2 = last ? nB : cB + (unsigned)(t + 2) * kstep; \
            const unsigned a3 = a2 + kstep, b3 = b2 + kstep; \
            const bool f1 = MIXED && (t + 1 >= NTB), f2 = MIXED && !last && (t + 2 >= NTB); (void)f1; (void)f2;
        if constexpr (MIXED) {
#pragma unroll 1
            for (int t = 0; t < NTB; t += 2) { PG8_TRIP_VARS() PG8_TRIP(false); }
            { const int l2 = lane_volatile(); E.mid(acc, cur, wr, wc, l2 & 15, l2 >> 4); }
#pragma unroll 1
            for (int t = NTB; t < nt; t += 2) { PG8_TRIP_VARS() PG8_TRIP(true); }
        } else {
#pragma unroll 1
            for (int t = 0; t < nt; t += 2) {
                if constexpr (DUALA) { if (t == MIDT) { const int l2 = lane_volatile(); E.mid(acc, cur, wr, wc, l2 & 15, l2 >> 4); } }
                PG8_TRIP_VARS() PG8_TRIP(F8);
            }
        }
#undef PG8_TRIP_VARS
#undef PG8_TRIP
        if constexpr (ALIGN_EPI) { if (wr == 0) PG8_BAR; }
        { const int l2 = lane_volatile(); E(acc, cur, ui, wr, wc, l2 & 15, l2 >> 4); }
        if (!has_next) break;
#pragma unroll
        for (int a = 0; a < 2; ++a)
#pragma unroll
            for (int b = 0; b < 2; ++b)
#pragma unroll
                for (int m = 0; m < 4; ++m)
#pragma unroll
                    for (int n = 0; n < 2; ++n) { acc[a][b][m][n] = zero4_asm(); }
        cur = nxt; cA = nA; cA2 = nA2; cB = nB; ++ui;
        if constexpr (ALIGN_EPI) { if (wr == 1) PG8_BAR; }
    }
    PG8_WAIT_V(0);
    if constexpr (!ALIGN_EPI) { if (wr == 0) PG8_BAR; }
    PG8_BAR;
#undef PG8_SA
#undef PG8_SB
#undef PG8_DMA
#undef PG8_STAGE_B
#undef PG8_STAGE_A
#undef PG8_LDA
#undef PG8_LDB
#undef PG8_MMA
#undef PG8_F8OP
#undef PG8_WAIT_V
#undef PG8_WAIT_L
#undef PG8_BAR
#undef PG8_SCHED
#undef PG8_GLOAD
#undef PG8_AOFF
}
}

constexpr size_t MiB = 1u << 20;
constexpr size_t WS_CTL = 0, CTL_ZERO_BYTES = 1 * MiB;
constexpr size_t WS_CS = 1 * MiB;
constexpr size_t WS_WTS = 3 * MiB;
constexpr size_t WS_LIST = 672 * MiB;
constexpr size_t WS_WIN = 12 * MiB;
constexpr size_t WS_WC = 37 * MiB, WS_WA = 41 * MiB, WS_WO = 45 * MiB;
constexpr size_t WS_RW = 49 * MiB;
constexpr size_t WS_RSTD = 50 * MiB;
constexpr size_t WS_W13 = 64 * MiB;
constexpr size_t WS_W2 = 320 * MiB;
constexpr size_t WS_N = 448 * MiB;
constexpr size_t WS_U = 512 * MiB, WS_CC = 576 * MiB, WS_Q = 640 * MiB;
constexpr size_t WS_K = 704 * MiB, WS_VT = 712 * MiB;
constexpr size_t WS_G = 720 * MiB;
constexpr size_t WS_H = 848 * MiB;
constexpr size_t WS_H8 = WS_H + 64 * MiB;
constexpr size_t WS_O8 = WS_H8 + 32 * MiB;
constexpr size_t WS_WIN8 = 24 * MiB;
constexpr size_t WS_N8 = 976 * MiB;
constexpr size_t WS_END = 1008 * MiB;
constexpr int CW_BAR = 4096;
constexpr int CW_CNT = 65536;

constexpr int RING_OFF = 0, RING_BYTES = 131072;
constexpr int LDSCTL_OFF = RING_BYTES, MISC_OFF = LDSCTL_OFF + 320;
constexpr int WSLOT_OFF = LDSCTL_OFF + 512;
constexpr int TAB_OFF = RING_BYTES + 1024;
constexpr int TOK_OFF = TAB_OFF + 1024;
constexpr int WT_OFF = TOK_OFF + MAX_UNITS * 1024;
constexpr int TOKA_OFF = WT_OFF + MAX_UNITS * 1024;
constexpr int WTA_OFF = TOKA_OFF + MAX_UNITS * 1024;
constexpr int LDS_BYTES = 159744;
static_assert(WTA_OFF + MAX_UNITS * 1024 <= LDS_BYTES, "LDS map");

#define GAS __attribute__((address_space(1)))
#define LAS __attribute__((address_space(3)))
typedef unsigned short bf16;
typedef unsigned v4u __attribute__((ext_vector_type(4)));
typedef unsigned v2u __attribute__((ext_vector_type(2)));
typedef float f32x4 __attribute__((ext_vector_type(4)));
typedef float f32x16 __attribute__((ext_vector_type(16)));
typedef short bf16x8 __attribute__((ext_vector_type(8)));
typedef GAS unsigned gu32;
#define RLX_AGENT __ATOMIC_RELAXED, __HIP_MEMORY_SCOPE_AGENT
#define LDS_WAIT() asm volatile("s_waitcnt lgkmcnt(0)" ::: "memory")
#define VM_WAIT() asm volatile("s_waitcnt vmcnt(0)" ::: "memory")
__device__ __forceinline__ unsigned pk2(float lo, float hi) { return pg8::cvt_pk_bf16(lo, hi); }
__device__ __forceinline__ float bflo(unsigned w) { return __uint_as_float(w << 16); }
__device__ __forceinline__ float bfhi(unsigned w) { return __uint_as_float(w & 0xffff0000u); }

#define XB_TMO      128
#define XB_XCNT(j)  (256  + 64 * (j))
#define XB_XSUB(j)  (1280 + 64 * (j))
#define XB_XGEN(j)  (2304 + 64 * (j))
#define XB_TOP      3328
#define XB_TOPGEN   3392
#define XCD_BAR_WORDS 3456
#define XB_SPIN_CAP (1u << 22)
__device__ __forceinline__ unsigned* xb_at(unsigned* p) { unsigned long long z; asm volatile("v_mov_b64 %0, 0" : "=v"(z)); return (unsigned*)((char*)p + z); }
__device__ __forceinline__ unsigned xb_ld(unsigned* p)              { return __hip_atomic_load(xb_at(p), __ATOMIC_RELAXED, __HIP_MEMORY_SCOPE_AGENT); }
__device__ __forceinline__ unsigned xb_add(unsigned* p, unsigned v) { return __hip_atomic_fetch_add(xb_at(p), v, __ATOMIC_RELAXED, __HIP_MEMORY_SCOPE_AGENT); }
__device__ __forceinline__ unsigned xb_xcc_id() { return (unsigned)__builtin_amdgcn_s_getreg((3 << 11) | 20) & 0xFu; }
#define XB_SPIN(cond, bar) do { unsigned _sp = 0; while (cond) { __builtin_amdgcn_s_sleep(1); \
    if ((++_sp & 255u) == 0u) { if (xb_ld(&(bar)[XB_TMO])) break; if (_sp > XB_SPIN_CAP) { (void)xb_add(&(bar)[XB_TMO], 1u); break; } } } } while (0)
struct XcdBarrier { unsigned* bar; unsigned x; volatile LAS unsigned* st; };
__device__ __forceinline__ XcdBarrier xcd_barrier_post(unsigned* bar, volatile LAS unsigned* st, int tid) {
    XcdBarrier b; b.bar = bar; b.x = xb_xcc_id(); b.st = st;
    if (tid == 0) (void)xb_add(&bar[XB_XCNT(b.x)], 1u);
    return b;
}
__device__ __forceinline__ void xcd_barrier_complete(unsigned* bar, unsigned x, unsigned& nloc, unsigned& nx) {
    const unsigned G = gridDim.x * gridDim.y * gridDim.z;
    unsigned sum, cnt, mine, sp = 0u;
    for (;;) {
        sum = 0u; cnt = 0u; mine = 0u;
#pragma unroll
        for (unsigned j = 0; j < 16; ++j) { const unsigned c = xb_ld(&bar[XB_XCNT(j)]); sum += c; cnt += (c > 0u) ? 1u : 0u; mine = (j == x) ? c : mine; }
        if (sum == G) break;
        __builtin_amdgcn_s_sleep(1);
        if ((++sp & 255u) == 0u) { if (xb_ld(&bar[XB_TMO])) break; if (sp > XB_SPIN_CAP) { (void)xb_add(&bar[XB_TMO], 1u); break; } }
    }
    nloc = mine > 0u ? mine : 1u; nx = cnt > 0u ? cnt : 1u;
}
__device__ __forceinline__ void xcd_barrier(const XcdBarrier& b, int tid) {
    asm volatile("s_waitcnt vmcnt(0)" ::: "memory");
    __syncthreads();
    if (tid == 0) {
        unsigned* bar = b.bar;
        __builtin_amdgcn_s_waitcnt(0);
        unsigned nloc = b.st[0], nx = b.st[1];
        if (nloc == 0u) { xcd_barrier_complete(bar, b.x, nloc, nx); b.st[0] = nloc; b.st[1] = nx; }
        const unsigned old = xb_add(&bar[XB_XSUB(b.x)], 1u);
        const unsigned gen = old / nloc;
        if (old + 1u == (gen + 1u) * nloc) {
            __builtin_amdgcn_fence(__ATOMIC_RELEASE, "agent");
            asm volatile("s_waitcnt vmcnt(0)" ::: "memory");
            const unsigned og = xb_add(&bar[XB_TOP], 1u);
            const unsigned tg = og / nx;
            if (og + 1u == (tg + 1u) * nx) xb_add(&bar[XB_TOPGEN], 1u);
            else XB_SPIN(xb_ld(&bar[XB_TOPGEN]) == tg, bar);
            __builtin_amdgcn_fence(__ATOMIC_ACQUIRE, "agent");
            xb_add(&bar[XB_XGEN(b.x)], 1u);
            asm volatile("s_waitcnt vmcnt(0)" ::: "memory");
        } else {
            XB_SPIN(xb_ld(&bar[XB_XGEN(b.x)]) == gen, bar);
            __builtin_amdgcn_fence(__ATOMIC_ACQUIRE, "agent");
            asm volatile("s_waitcnt vmcnt(0)" ::: "memory");
        }
    }
    __syncthreads();
}

struct Args { const void* in[19]; float* out; unsigned char* ws; int ph_lo, ph_hi; };

__device__ __forceinline__ float xshfl(float v, int k, int lane) { return __int_as_float(__builtin_amdgcn_ds_bpermute((lane ^ k) << 2, __float_as_int(v))); }
__device__ __forceinline__ float wave_sum(float v, int lane) {
#pragma unroll
    for (int o = 1; o < 64; o <<= 1) v += xshfl(v, o, lane);
    return v;
}

struct CvtItem { const float* src; bf16* dst; unsigned char* dst8; const float* kscale; float oscale; int N, K, k0, perm; };
__device__ __forceinline__ void cvt_load(const CvtItem& d, f32x4 (&v)[16], int lane) {
    const int kk = lane >> 4, n4 = lane & 15;
#pragma unroll
    for (int i = 0; i < 16; ++i) v[i] = __builtin_nontemporal_load((const GAS f32x4*)(d.src + (size_t)(4 * i + kk) * d.N + 4 * n4));
}
__device__ __forceinline__ void cvt_finish(const CvtItem& d, f32x4 (&v)[16], LAS float* scr, int lane) {
    const int kk = lane >> 4, n4 = lane & 15;
    if (d.kscale) {
#pragma unroll
        for (int i = 0; i < 16; ++i) v[i] = v[i] * d.kscale[d.k0 + 4 * i + kk]; }
#pragma unroll
    for (int i = 0; i < 16; ++i) { const int k = 4 * i + kk; *(LAS f32x4*)(scr + k * 64 + 4 * (n4 ^ ((k >> 3) & 7))) = v[i]; }
    LDS_WAIT(); asm volatile("" ::: "memory");
    const int c = lane & 7, nlo = lane >> 3;
#pragma unroll
    for (int jj = 0; jj < 2; ++jj) { float x[4][8];
#pragma unroll
        for (int j = 0; j < 4; ++j) { const int pos = nlo + 8 * (4 * jj + j); int col = pos; if (d.perm && pos < 16) col = (pos >> 1) + 8 * (pos & 1);
            const LAS float* s = scr + (8 * c) * 64 + (col ^ (4 * c));
#pragma unroll
            for (int i = 0; i < 8; ++i) x[j][i] = s[i * 64]; }
#pragma unroll
        for (int j = 0; j < 4; ++j) { const int pos = nlo + 8 * (4 * jj + j);
            if (d.dst8) { const float sc = d.oscale;
                const v2u o8 = pg8::pack8_f8((f32x4){x[j][0] * sc, x[j][1] * sc, x[j][2] * sc, x[j][3] * sc}, (f32x4){x[j][4] * sc, x[j][5] * sc, x[j][6] * sc, x[j][7] * sc});
                __builtin_nontemporal_store(o8, (GAS v2u*)(d.dst8 + (size_t)pos * d.K + 8 * c)); }
            else {
            v4u o; o.x = pg8::cvt_pk_bf16_c(x[j][0], x[j][1]); o.y = pg8::cvt_pk_bf16_c(x[j][2], x[j][3]); o.z = pg8::cvt_pk_bf16_c(x[j][4], x[j][5]); o.w = pg8::cvt_pk_bf16_c(x[j][6], x[j][7]);
            __builtin_nontemporal_store(o, (GAS v4u*)(d.dst + (size_t)pos * d.K + 8 * c)); } } }
    LDS_WAIT(); asm volatile("" ::: "memory");
}
__device__ __forceinline__ int inproj_srccol(int np) {
    if (np < 2048) { const int t = np >> 8, r = np & 255; return (r < 128) ? (t * 128 + r) : (2048 + t * 128 + (r - 128)); }
    return 1024 + (np - 2048);
}
__device__ __forceinline__ int inproj8_srccol0(int n8) { return 3072 + n8; }

__device__ __forceinline__ void sincos_d(double ang, float& s, float& c) {
    const double k = __builtin_rint(ang * 0.6366197723675814);
    double r = __builtin_fma(-k, 1.5707963267948966, ang); r = __builtin_fma(-k, 6.123233995736766e-17, r);
    const double r2 = r * r;
    double sp = -1.0 / 1307674368000.0; sp = sp * r2 + 1.0 / 6227020800.0; sp = sp * r2 - 1.0 / 39916800.0; sp = sp * r2 + 1.0 / 362880.0; sp = sp * r2 - 1.0 / 5040.0; sp = sp * r2 + 1.0 / 120.0; sp = sp * r2 - 1.0 / 6.0; sp = sp * r2 * r + r;
    double cp = 1.0 / 20922789888000.0; cp = cp * r2 - 1.0 / 87178291200.0; cp = cp * r2 + 1.0 / 479001600.0; cp = cp * r2 - 1.0 / 3628800.0; cp = cp * r2 + 1.0 / 40320.0; cp = cp * r2 - 1.0 / 720.0; cp = cp * r2 + 1.0 / 24.0; cp = cp * r2 - 0.5; cp = cp * r2 + 1.0;
    const int q = (int)((long long)k & 3);
    const double ss = (q == 0) ? sp : (q == 1) ? cp : (q == 2) ? -sp : -cp;
    const double cc = (q == 0) ? cp : (q == 1) ? -sp : (q == 2) ? -cp : sp;
    s = (float)ss; c = (float)cc;
}

struct RowIn { f32x4 v[4]; v2u h[4]; unsigned a[4], b[4]; };
template <int MODE> __device__ __forceinline__ void norm_load(RowIn& r, int lane, const float* xin, const bf16* hin, const unsigned char* s0, const unsigned char* s1) {
    if (MODE == 0) { const GAS f32x4* xr = (const GAS f32x4*)xin + lane;
#pragma unroll
        for (int j = 0; j < 4; ++j) r.v[j] = xr[64 * j]; }
    else { const GAS v2u* hr = (const GAS v2u*)hin + lane; const GAS unsigned* a = (const GAS unsigned*)s0 + lane; const GAS unsigned* b = (const GAS unsigned*)s1 + lane;
#pragma unroll
        for (int j = 0; j < 4; ++j) { r.h[j] = hr[64 * j]; r.a[j] = a[64 * j]; r.b[j] = b[64 * j]; } }
}
template <int MODE> __device__ __forceinline__ void norm_finish(RowIn& r, int lane, bf16* hsum, const f32x4 (&gg)[4], bf16* nout, unsigned char* n8out, float* fout) {
    f32x4 v[4]; float ss = 0.f;
    if (MODE == 0) {
#pragma unroll
        for (int j = 0; j < 4; ++j) v[j] = r.v[j]; }
    else {
#pragma unroll
        for (int j = 0; j < 4; ++j) { const v2u h = r.h[j]; typedef float f2 __attribute__((ext_vector_type(2)));
            const f2 x0 = __builtin_amdgcn_cvt_pk_f32_fp8((int)r.a[j], false), x1 = __builtin_amdgcn_cvt_pk_f32_fp8((int)r.a[j], true);
            const f2 y0 = __builtin_amdgcn_cvt_pk_f32_fp8((int)r.b[j], false), y1 = __builtin_amdgcn_cvt_pk_f32_fp8((int)r.b[j], true);
            v[j] = (f32x4){bflo(h.x), bfhi(h.x), bflo(h.y), bfhi(h.y)} + ((f32x4){x0.x, x0.y, x1.x, x1.y} + (f32x4){y0.x, y0.y, y1.x, y1.y}) * (1.0f / pg8::SLAB_SCALE); } }
    if (MODE == 1) { GAS v2u* o = (GAS v2u*)hsum + lane;
#pragma unroll
        for (int j = 0; j < 4; ++j) { v2u w; w.x = pk2(v[j].x, v[j].y); w.y = pk2(v[j].z, v[j].w); o[64 * j] = w; v[j] = (f32x4){bflo(w.x), bfhi(w.x), bflo(w.y), bfhi(w.y)}; } }
#pragma unroll
    for (int j = 0; j < 4; ++j) ss += (v[j].x * v[j].x + v[j].y * v[j].y) + (v[j].z * v[j].z + v[j].w * v[j].w);
    const float rstd = 1.f / sqrtf(wave_sum(ss, lane) * (1.f / D) + RMS_EPS);
#pragma unroll
    for (int j = 0; j < 4; ++j) v[j] = v[j] * rstd * gg[j];
    if (MODE != 2) { GAS v2u* o = (GAS v2u*)nout + lane; GAS int* o8 = (GAS int*)n8out + lane;
#pragma unroll
        for (int j = 0; j < 4; ++j) { v2u w; w.x = pk2(v[j].x, v[j].y); w.y = pk2(v[j].z, v[j].w); o[64 * j] = w;
            int w8 = __builtin_bit_cast(int, v[j].x); w8 = __builtin_amdgcn_cvt_pk_fp8_f32(v[j].x, v[j].y, w8, false); w8 = __builtin_amdgcn_cvt_pk_fp8_f32(v[j].z, v[j].w, w8, true); o8[64 * j] = w8; } }
    else { GAS f32x4* o = (GAS f32x4*)fout + lane;
#pragma unroll
        for (int j = 0; j < 4; ++j) o[64 * j] = v[j]; }
}
#define NORM_LOAD2(ra_, rb_, m_) do { const int ma_ = (m_), mb_ = ma_ + NGW; \
        norm_load<MODE>(ra_, lane, MODE == 0 ? xin + (size_t)ma_ * D : nullptr, MODE ? h16 + (size_t)ma_ * D : nullptr, MODE ? slab + (size_t)(2 * ma_) * D : nullptr, MODE ? slab + (size_t)(2 * ma_ + 1) * D : nullptr); \
        if (mb_ < T) norm_load<MODE>(rb_, lane, MODE == 0 ? xin + (size_t)mb_ * D : nullptr, MODE ? h16 + (size_t)mb_ * D : nullptr, MODE ? slab + (size_t)(2 * mb_) * D : nullptr, MODE ? slab + (size_t)(2 * mb_ + 1) * D : nullptr); } while (0)
#define NORM_FIN2(ra_, rb_, m_) do { const int ma_ = (m_), mb_ = ma_ + NGW; \
        norm_finish<MODE>(ra_, lane, MODE == 1 ? h16 + (size_t)ma_ * D : nullptr, gg, MODE != 2 ? nout + (size_t)ma_ * D : nullptr, MODE != 2 ? n8out + (size_t)ma_ * D : nullptr, MODE == 2 ? fout + (size_t)ma_ * D : nullptr); \
        if (mb_ < T) norm_finish<MODE>(rb_, lane, MODE == 1 ? h16 + (size_t)mb_ * D : nullptr, gg, MODE != 2 ? nout + (size_t)mb_ * D : nullptr, MODE != 2 ? n8out + (size_t)mb_ * D : nullptr, MODE == 2 ? fout + (size_t)mb_ * D : nullptr); } while (0)
template <int MODE> __device__ __forceinline__ void norm_rows(int lane, int gw, int NGW, const float* xin, bf16* h16, const unsigned char* slab, const float* g, bf16* nout, unsigned char* n8out, float* fout) {
    int m = gw; if (m >= T) return;
    f32x4 gg[4];
    { const GAS f32x4* gr = (const GAS f32x4*)g + lane;
#pragma unroll
      for (int j = 0; j < 4; ++j) gg[j] = gr[64 * j]; }
    RowIn a0, a1, b0, b1;
    NORM_LOAD2(a0, a1, m);
    for (;;) {
        const int mn = m + 2 * NGW; const bool hasn = mn < T;
        if (hasn) NORM_LOAD2(b0, b1, mn);
        NORM_FIN2(a0, a1, m);
        if (!hasn) break;
        m = mn + 2 * NGW; const bool has2 = m < T;
        if (has2) NORM_LOAD2(a0, a1, m);
        NORM_FIN2(b0, b1, mn);
        if (!has2) break;
    }
}
#undef NORM_LOAD2
#undef NORM_FIN2

constexpr int RT_BROW = 528, RT_BHALF = 80 * RT_BROW, RT_LG_OFF = 86016, RT_LGROW = 81;
__device__ __forceinline__ void router_block(LAS unsigned char* lds, int tid, int r0, const bf16* H, const bf16* WR, const float* bg, const float* broute,
                                             unsigned* cnt, int* lists, float* wts, float* rstd_out) {
    const int lane = tid & 63, wave = __builtin_amdgcn_readfirstlane(tid >> 6), fr = lane & 15, fq = lane >> 4;
    const bf16* hrow = H + (size_t)(r0 + wave * 16 + fr) * D + 8 * fq;
    LAS unsigned* cntB = (LAS unsigned*)(lds + TAB_OFF); LAS unsigned* baseB = cntB + 64;
    if (tid < 64) cntB[tid] = 0u;
    f32x4 acc[5];
#pragma unroll
    for (int nb = 0; nb < 5; ++nb) acc[nb] = (f32x4){0.f, 0.f, 0.f, 0.f};
    float ssq = 0.f;
    v4u av[8]; v4u bw[10];
#define RT_LOADB(c_) do { _Pragma("unroll") for (int i = 0; i < 10; ++i) { const int q = tid + 512 * i; const int hl = q / 2560, rem = q % 2560, n = rem >> 5, ch = rem & 31; \
            bw[i] = *(const GAS v4u*)(WR + ((size_t)hl * 80 + n) * D + (c_) * 256 + ch * 8); } } while (0)
#pragma unroll
    for (int ks = 0; ks < 8; ++ks) av[ks] = *(const GAS v4u*)(hrow + ks * 32);
    RT_LOADB(0);
#pragma unroll
    for (int c = 0; c < 4; ++c) {
        __syncthreads();
#pragma unroll
        for (int i = 0; i < 10; ++i) { const int q = tid + 512 * i; const int hl = q / 2560, rem = q % 2560, n = rem >> 5, ch = rem & 31;
            *(LAS v4u*)(lds + hl * RT_BHALF + n * RT_BROW + ch * 16) = bw[i]; }
        __syncthreads();
        if (c < 3) RT_LOADB(c + 1);
#pragma unroll
        for (int ks = 0; ks < 8; ++ks) {
            const v4u a = av[ks];
            if (c < 3) av[ks] = *(const GAS v4u*)(hrow + (c + 1) * 256 + ks * 32);
            { const float x0 = bflo(a.x), x1 = bfhi(a.x), x2 = bflo(a.y), x3 = bfhi(a.y), x4 = bflo(a.z), x5 = bfhi(a.z), x6 = bflo(a.w), x7 = bfhi(a.w);
              ssq += (x0 * x0 + x1 * x1) + (x2 * x2 + x3 * x3) + (x4 * x4 + x5 * x5) + (x6 * x6 + x7 * x7); }
            const bf16x8 ah = __builtin_bit_cast(bf16x8, a);
#pragma unroll
            for (int nb = 0; nb < 5; ++nb) {
                const bf16x8 bh = *(const LAS bf16x8*)(lds + (nb * 16 + fr) * RT_BROW + ks * 64 + fq * 16);
                const bf16x8 bl = *(const LAS bf16x8*)(lds + RT_BHALF + (nb * 16 + fr) * RT_BROW + ks * 64 + fq * 16);
                acc[nb] = __builtin_amdgcn_mfma_f32_16x16x32_bf16(ah, bh, acc[nb], 0, 0, 0);
                acc[nb] = __builtin_amdgcn_mfma_f32_16x16x32_bf16(ah, bl, acc[nb], 0, 0, 0);
            }
        }
    }
#undef RT_LOADB
    ssq += xshfl(ssq, 16, lane); ssq += xshfl(ssq, 32, lane);
    const float rs = 1.f / sqrtf(ssq * (1.f / D) + RMS_EPS);
    LAS float* LG = (LAS float*)(lds + RT_LG_OFF) + wave * 16 * RT_LGROW;
#pragma unroll
    for (int nb = 0; nb < 5; ++nb)
#pragma unroll
        for (int i = 0; i < 4; ++i) LG[(4 * fq + i) * RT_LGROW + nb * 16 + fr] = acc[nb][i];
    LDS_WAIT(); asm volatile("" ::: "memory");
    int ea = 0, eb = 0; unsigned ra = 0u, rb = 0u; float wa = 0.f, wb = 0.f;
    if (lane < 16) {
        const LAS float* lr = LG + lane * RT_LGROW;
        unsigned long long z_; asm volatile("v_mov_b64 %0, 0" : "=v"(z_)); const float* bgz = (const float*)((const char*)bg + z_);
        float lg[8];
#pragma unroll
        for (int e = 0; e < 8; ++e) lg[e] = lr[e] * rs + bgz[e];
        int gi = 0; float gm = lg[0];
#pragma unroll
        for (int e = 1; e < 8; ++e) if (lg[e] > gm) { gm = lg[e]; gi = e; }
        float gs = 0.f;
#pragma unroll
        for (int e = 0; e < 8; ++e) gs += __expf(lg[e] - gm);
        const float pgroup = 1.f / gs;
        float le[8];
#pragma unroll
        for (int e = 0; e < 8; ++e) le[e] = lr[8 + gi * 8 + e] * rs + broute[gi * 8 + e];
        int i1 = 0; float m1 = le[0];
#pragma unroll
        for (int e = 1; e < 8; ++e) if (le[e] > m1) { m1 = le[e]; i1 = e; }
        int i2 = -1; float m2 = -INFINITY;
#pragma unroll
        for (int e = 0; e < 8; ++e) if (e != i1 && le[e] > m2) { m2 = le[e]; i2 = e; }
        const float e2 = __expf(m2 - m1); const float inv = 1.f / (1.f + e2);
        ea = gi * 8 + i1; eb = gi * 8 + i2; wa = pgroup * inv; wb = pgroup * e2 * inv;
        ra = __hip_atomic_fetch_add(cntB + ea, 1u, __ATOMIC_RELAXED, __HIP_MEMORY_SCOPE_WORKGROUP); rb = __hip_atomic_fetch_add(cntB + eb, 1u, __ATOMIC_RELAXED, __HIP_MEMORY_SCOPE_WORKGROUP);
    }
    __syncthreads();
    if (tid < 64) { const unsigned n = cntB[tid]; unsigned b0 = 0u; if (n) b0 = atomicAdd(cnt + tid * 16, n); baseB[tid] = b0; }
    __syncthreads();
    if (lane < 16) {
        const int t = r0 + wave * 16 + lane;
        const unsigned sa = baseB[ea] + ra, sb = baseB[eb] + rb;
        const unsigned rsb = __float_as_uint(rs);
        ((GAS v4u*)lists)[(size_t)ea * LIST_CAP + sa] = (v4u){(unsigned)(2 * t), __float_as_uint(wa), rsb, 0u};
        ((GAS v4u*)lists)[(size_t)eb * LIST_CAP + sb] = (v4u){(unsigned)(2 * t + 1), __float_as_uint(wb), rsb, 0u};
        (void)wts; (void)rstd_out;
    }
}

constexpr int KROW = 144, VROW = 400, KIMG = 192 * KROW, VIMG = 64 * VROW;
#define ATT_LOADKV(u_) do { const int kh_ = (u_) & 1, c_ = ((u_) >> 1) & 127, b_ = (u_) >> 8; \
        _Pragma("unroll") for (int i = 0; i < 3; ++i) { const int q = tid + 512 * i; const int row = q >> 3, ch = q & 7; int cj = c_ - 2 + (row >> 6); cj = cj < 0 ? 0 : cj; \
            kreg[i] = *(const GAS v4u*)(Kb + ((size_t)(b_ * SEQ + cj * 64 + (row & 63))) * 128 + kh_ * 64 + ch * 8); } \
        _Pragma("unroll") for (int i = 0; i < 3; ++i) { const int q = tid + 512 * i; const int d = q / 24, rem = q % 24, j = rem >> 3, ch = rem & 7; int cj = c_ - 2 + j; cj = cj < 0 ? 0 : cj; \
            vreg[i] = *(const GAS v4u*)(VT + ((size_t)((b_ * 2 + kh_) * 64 + d)) * SEQ + cj * 64 + ch * 8); } } while (0)
__device__ __forceinline__ void attn_phase(LAS unsigned char* lds, int tid, int vcu, int G, const unsigned char* Q, unsigned char* O, const bf16* Kb, const bf16* VT, const float* sinks) {
    const int lane = tid & 63, wid = __builtin_amdgcn_readfirstlane(tid >> 6), r32 = lane & 31, hi = lane >> 5;
    constexpr int NUNITS = BATCH * (SEQ / CHUNK) * NKV;
    const int sig = (r32 & 19) | ((r32 & 4) << 1) | ((r32 & 8) >> 1);
    const LAS unsigned char* kbase = lds + sig * KROW + hi * 16;
    const LAS unsigned char* vbase = lds + KIMG + r32 * VROW + hi * 16;
    v4u kreg[3], vreg[3];
    const float sink0 = sinks[wid] * LOG2E, sink1 = sinks[8 + wid] * LOG2E;
#define ATT_UNIT(k_) ((G == 256) ? ((k_) < 4 ? (((vcu >> 5) >> 1) << 8) | ((64 * ((vcu >> 5) & 1) + (((vcu & 31) + 32 * (k_)) >> 1)) << 1) | (((vcu & 31) + 32 * (k_)) & 1) : NUNITS) : vcu + (k_) * G)
    if (ATT_UNIT(0) < NUNITS) ATT_LOADKV(ATT_UNIT(0));
    for (int ku = 0; ; ++ku) {
        const int u = ATT_UNIT(ku); if (u >= NUNITS) break;
        const int kh = u & 1, c = (u >> 1) & 127, b = u >> 8;
        __syncthreads();
#pragma unroll
        for (int i = 0; i < 3; ++i) { const int q = tid + 512 * i; const int row = q >> 3, ch = q & 7; *(LAS v4u*)(lds + row * KROW + ch * 16) = kreg[i]; }
#pragma unroll
        for (int i = 0; i < 3; ++i) { const int q = tid + 512 * i; const int d = q / 24, rem = q % 24, j = rem >> 3, ch = rem & 7; *(LAS v4u*)(lds + KIMG + d * VROW + j * 128 + ch * 16) = vreg[i]; }
        __syncthreads();
        const int head = kh * 8 + wid;
        const size_t tok0 = (size_t)b * SEQ + c * 64 + r32;
        bf16x8 qr[2][4];
        v2u qraw[2][4];
#pragma unroll
        for (int qt = 0; qt < 2; ++qt)
#pragma unroll
            for (int d0 = 0; d0 < 4; ++d0) qraw[qt][d0] = *(const GAS v2u*)(Q + (tok0 + qt * 32) * D + head * 64 + d0 * 16 + hi * 8);
#pragma unroll
        for (int qt = 0; qt < 2; ++qt)
#pragma unroll
            for (int d0 = 0; d0 < 4; ++d0) { const v2u q8 = qraw[qt][d0];
                typedef float f2 __attribute__((ext_vector_type(2))); constexpr float QI = 1.0f / pg8::Q8_SCALE;
                const f2 a0 = __builtin_amdgcn_cvt_pk_f32_fp8((int)q8.x, false), a1 = __builtin_amdgcn_cvt_pk_f32_fp8((int)q8.x, true), b0 = __builtin_amdgcn_cvt_pk_f32_fp8((int)q8.y, false), b1 = __builtin_amdgcn_cvt_pk_f32_fp8((int)q8.y, true);
                v4u w; w.x = pk2(a0.x * QI, a0.y * QI); w.y = pk2(a1.x * QI, a1.y * QI); w.z = pk2(b0.x * QI, b0.y * QI); w.w = pk2(b1.x * QI, b1.y * QI);
                qr[qt][d0] = __builtin_bit_cast(bf16x8, w); }
        { const int un = ATT_UNIT(ku + 1); if (un < NUNITS) ATT_LOADKV(un); }
        const float sinkl2 = kh ? sink1 : sink0;
#pragma unroll
        for (int qt = 0; qt < 2; ++qt) {
            unsigned char* op = O + (tok0 + qt * 32) * D + head * 64;
            f32x16 s[6];
#pragma unroll
            for (int t = 0; t < 6; ++t) {
                s[t] = (f32x16){0.f, 0.f, 0.f, 0.f, 0.f, 0.f, 0.f, 0.f, 0.f, 0.f, 0.f, 0.f, 0.f, 0.f, 0.f, 0.f};
#pragma unroll
                for (int d0 = 0; d0 < 4; ++d0) { const bf16x8 kf = *(const LAS bf16x8*)(kbase + t * 32 * KROW + d0 * 32);
                    s[t] = __builtin_amdgcn_mfma_f32_32x32x16_bf16(kf, qr[qt][d0], s[t], 0, 0, 0); }
            }
            if (c < 2) {
                asm volatile("" ::: "memory");
#pragma unroll
                for (int t = 0; t < 6; ++t) if (c - 2 + (t >> 1) < 0) {
#pragma unroll
                    for (int r = 0; r < 16; ++r) s[t][r] = -INFINITY; } }
            float m = sinkl2;
#pragma unroll
            for (int t = 0; t < 6; ++t)
#pragma unroll
                for (int r = 0; r < 16; ++r) m = fmaxf(m, s[t][r]);
            m = fmaxf(m, xshfl(m, 32, lane));
            float l = 0.f;
#pragma unroll
            for (int t = 0; t < 6; ++t)
#pragma unroll
                for (int r = 0; r < 16; ++r) { s[t][r] = __builtin_amdgcn_exp2f(s[t][r] - m); l += s[t][r]; }
            l += xshfl(l, 32, lane);
            l += __builtin_amdgcn_exp2f(sinkl2 - m);
            const float rl = 1.f / l;
            f32x16 o[2];
#pragma unroll
            for (int dt = 0; dt < 2; ++dt) o[dt] = (f32x16){0.f, 0.f, 0.f, 0.f, 0.f, 0.f, 0.f, 0.f, 0.f, 0.f, 0.f, 0.f, 0.f, 0.f, 0.f, 0.f};
#pragma unroll
            for (int t = 0; t < 6; ++t)
#pragma unroll
                for (int ks = 0; ks < 2; ++ks) {
                    v4u pw; pw.x = pk2(s[t][8 * ks + 0], s[t][8 * ks + 1]); pw.y = pk2(s[t][8 * ks + 2], s[t][8 * ks + 3]); pw.z = pk2(s[t][8 * ks + 4], s[t][8 * ks + 5]); pw.w = pk2(s[t][8 * ks + 6], s[t][8 * ks + 7]);
                    const bf16x8 pf = __builtin_bit_cast(bf16x8, pw);
#pragma unroll
                    for (int dt = 0; dt < 2; ++dt) { const bf16x8 vf = *(const LAS bf16x8*)(vbase + dt * 32 * VROW + (t * 32 + ks * 16) * 2);
                        o[dt] = __builtin_amdgcn_mfma_f32_32x32x16_bf16(vf, pf, o[dt], 0, 0, 0); }
                }
#pragma unroll
            for (int dt = 0; dt < 2; ++dt)
#pragma unroll
                for (int g = 0; g < 4; ++g) { const float o0_ = o[dt][4 * g] * rl; int w = __builtin_bit_cast(int, o0_);
                    w = __builtin_amdgcn_cvt_pk_fp8_f32(o0_, o[dt][4 * g + 1] * rl, w, false); w = __builtin_amdgcn_cvt_pk_fp8_f32(o[dt][4 * g + 2] * rl, o[dt][4 * g + 3] * rl, w, true);
                    *(GAS int*)(op + dt * 32 + 8 * g + 4 * hi) = w; }
        }
    }
    __syncthreads();
}
#undef ATT_LOADKV
#undef ATT_UNIT

__device__ __forceinline__ void conv_item(int tid, int item, const bf16* U, const bf16* CCb, const float* cw, bf16* AO) {
    const int cg = tid & 127, rq = tid >> 7; const int t0 = item * 64 + rq * 16; const int s0 = t0 & (SEQ - 1); const int ch = cg * 8;
#define CV_UNPACK8(dst_, x_) do { dst_[0] = bflo((x_).x); dst_[1] = bfhi((x_).x); dst_[2] = bflo((x_).y); dst_[3] = bfhi((x_).y); dst_[4] = bflo((x_).z); dst_[5] = bfhi((x_).z); dst_[6] = bflo((x_).w); dst_[7] = bfhi((x_).w); } while (0)
    const auto rU = __builtin_amdgcn_make_buffer_rsrc((void*)U, 0, 0xffffffff, 0x00020000);
    const auto rC = __builtin_amdgcn_make_buffer_rsrc((void*)CCb, 0, 0xffffffff, 0x00020000);
    const int oc = 2 * (t0 * D + ch);
    v4u xu[16], x2 = {0u, 0u, 0u, 0u}, x1 = {0u, 0u, 0u, 0u}; v4u xc[16];
    if (s0 >= 2) x2 = __builtin_bit_cast(v4u, __builtin_amdgcn_raw_buffer_load_b128(rU, oc - 4 * D, 0, 0));
    if (s0 >= 1) x1 = __builtin_bit_cast(v4u, __builtin_amdgcn_raw_buffer_load_b128(rU, oc - 2 * D, 0, 0));
#pragma unroll
    for (int r = 0; r < 16; ++r) { xu[r] = __builtin_bit_cast(v4u, __builtin_amdgcn_raw_buffer_load_b128(rU, oc, r * D * 2, 0)); xc[r] = __builtin_bit_cast(v4u, __builtin_amdgcn_raw_buffer_load_b128(rC, oc, r * D * 2, 0)); }
    float w[3][8];
#pragma unroll
    for (int j = 0; j < 3; ++j) { const f32x4 a = *(const GAS f32x4*)(cw + j * D + ch), b = *(const GAS f32x4*)(cw + j * D + ch + 4);
        w[j][0] = a.x; w[j][1] = a.y; w[j][2] = a.z; w[j][3] = a.w; w[j][4] = b.x; w[j][5] = b.y; w[j][6] = b.z; w[j][7] = b.w; }
    float p2[8], p1[8];
    CV_UNPACK8(p2, x2); CV_UNPACK8(p1, x1);
#pragma unroll
    for (int r = 0; r < 16; ++r) {
        float u0[8]; CV_UNPACK8(u0, xu[r]);
        float c0[8]; CV_UNPACK8(c0, xc[r]);
        float y[8];
#pragma unroll
        for (int k = 0; k < 8; ++k) { y[k] = c0[k] * (w[0][k] * p2[k] + w[1][k] * p1[k] + w[2][k] * u0[k]); p2[k] = p1[k]; p1[k] = u0[k]; }
        v4u ov; ov.x = pk2(y[0], y[1]); ov.y = pk2(y[2], y[3]); ov.z = pk2(y[4], y[5]); ov.w = pk2(y[6], y[7]);
        *(GAS v4u*)(AO + (size_t)(t0 + r) * D + ch) = ov;
    }
#undef CV_UNPACK8
}

constexpr int NWAVES = 8;
constexpr int PH_PER_LAYER = 9;
constexpr int N_PHASES = 1 + DEPTH * PH_PER_LAYER + 1;

__device__ __forceinline__ int my_lane_volatile() { int l; asm volatile("v_mbcnt_lo_u32_b32 %0, -1, 0\n\tv_mbcnt_hi_u32_b32 %0, -1, %0" : "=v"(l)); return l; }
typedef __attribute__((address_space(4))) const Args* KArgs;
constexpr int CI_IN = 16 * 100, CI_SQ = 16 * 16, CI_13 = 16 * 16 * 64, CI_2 = 8 * 16 * 64, CI_SMALL = CI_IN + 3 * CI_SQ, CI_EXP = CI_13 + CI_2;
__device__ __forceinline__ CvtItem cvt_decode(KArgs A, unsigned char* ws, int kind, int it) {
    CvtItem d; d.kscale = nullptr; d.perm = 0; d.dst8 = nullptr; d.dst = nullptr; d.oscale = 1.f;
    const int per_layer = kind == 0 ? CI_SMALL : CI_EXP; const int l = it / per_layer; int r = it % per_layer;
    if (kind == 0) {
        if (r < CI_IN) { const int kb = r / 100, grp = r % 100; d.N = IN_COLS; d.K = D; d.k0 = kb * 64;
            if (grp < 48) { const int n0 = grp * 64;
                d.src = (const float*)A->in[3] + (size_t)l * D * IN_COLS + (size_t)d.k0 * IN_COLS + inproj_srccol(n0); d.dst = (bf16*)(ws + WS_WIN) + (size_t)l * 3072 * D + (size_t)n0 * D + d.k0; }
            else { const int n8 = (grp - 48) * 64; d.perm = (n8 < 1152) ? 1 : 0; d.oscale = pg8::WIN8_SCALE;
                d.src = (const float*)A->in[3] + (size_t)l * D * IN_COLS + (size_t)d.k0 * IN_COLS + inproj8_srccol0(n8); d.dst8 = (unsigned char*)(ws + WS_WIN8) + (size_t)l * 3328 * D + (size_t)n8 * D + d.k0; } }
        else { r -= CI_IN; const int w = r / CI_SQ; const int rr = r % CI_SQ; const int kb = rr / 16, n0 = (rr % 16) * 64; d.N = D; d.k0 = kb * 64;
            d.src = (const float*)A->in[7 + w] + (size_t)l * D * D + (size_t)d.k0 * D + n0;
            if (w == 0) { d.K = 1536; d.dst = (bf16*)(ws + WS_WC + (size_t)l * D * 3072) + (size_t)n0 * 1536 + d.k0; }
            else if (w == 1) { d.K = 3072; d.oscale = pg8::WA_SCALE; d.dst8 = (unsigned char*)(ws + WS_WC + (size_t)l * D * 3072) + (size_t)n0 * 3072 + 2048 + d.k0; }
            else { d.K = D; d.dst = (bf16*)(ws + WS_WO) + (size_t)l * D * D + (size_t)n0 * D + d.k0; } }
    } else {
        if (r < CI_13) { const int e = r / 256, rr = r % 256; const int kb = rr / 16, n0 = (rr % 16) * 64; const int which = (n0 >> 7) & 1; const int sc0 = (n0 >> 8) * 128 + (n0 & 127);
            d.N = FF; d.K = D; d.k0 = kb * 64;
            d.src = (const float*)A->in[15 + which] + ((size_t)(l * NEXP + e)) * D * FF + (size_t)d.k0 * FF + sc0; d.oscale = pg8::W13_SCALE;
            d.dst8 = (unsigned char*)(ws + WS_W13) + ((size_t)(l * NEXP + e)) * 1024 * D + (size_t)n0 * D + d.k0; }
        else { r -= CI_13; const int e = r / 128, rr = r % 128; const int kb = rr / 16, n0 = (rr % 16) * 64; d.N = D; d.K = FF; d.k0 = kb * 64;
            d.src = (const float*)A->in[17] + ((size_t)(l * NEXP + e)) * FF * D + (size_t)d.k0 * D + n0; d.oscale = pg8::W2_SCALE;
            d.dst8 = (unsigned char*)(ws + WS_W2) + ((size_t)(l * NEXP + e)) * D * FF + (size_t)n0 * FF + d.k0; }
    }
    return d;
}
__device__ __forceinline__ void convert_items(KArgs A, unsigned char* ws, LAS unsigned char* lds, int kind, int lane, int wave, int gw, int NGW, int end) {
    LAS float* scr = (LAS float*)(lds + RING_OFF + wave * 16384);
    int it0 = gw; if (it0 >= end) return;
    f32x4 va[16], vb[16];
    CvtItem d0 = cvt_decode(A, ws, kind, it0), d1 = d0; cvt_load(d0, va, lane);
    for (;;) {
        const int it1 = it0 + NGW; const bool has1 = it1 < end;
        if (has1) { d1 = cvt_decode(A, ws, kind, it1); cvt_load(d1, vb, lane); }
        cvt_finish(d0, va, scr, lane);
        if (!has1) break;
        it0 = it1 + NGW; const bool has0 = it0 < end;
        if (has0) { d0 = cvt_decode(A, ws, kind, it0); cvt_load(d0, va, lane); }
        cvt_finish(d1, vb, scr, lane);
        if (!has0) break;
    }
}
__device__ __forceinline__ KArgs kargs() { KArgs p = (KArgs)__builtin_amdgcn_kernarg_segment_ptr(); asm volatile("" : "+s"(p)); return p; }

template <int L> struct LayerTag { static constexpr int value = L; };
__global__ void __launch_bounds__(NWAVES * 64, 2) fwd_kernel(Args args_unused) {
    extern __shared__ __attribute__((aligned(16))) unsigned char lds_raw[];
    LAS unsigned char* lds = (LAS unsigned char*)lds_raw;
#define HW_SLOT() ((int)__builtin_amdgcn_s_getreg((5 << 11) | 4) & 63)
#define MY_TID() (((volatile LAS int*)(lds + WSLOT_OFF))[HW_SLOT()] * 64 + my_lane_volatile())
    {   const int tid0 = threadIdx.x;
        { unsigned z0_; asm volatile("v_mov_b32 %0, 0" : "=v"(z0_));
          for (int u = tid0; u < (TAB_OFF - LDSCTL_OFF) / 4; u += NWAVES * 64) ((LAS unsigned*)(lds + LDSCTL_OFF))[u] = z0_; }
        __syncthreads();
        if ((tid0 & 63) == 0) ((volatile LAS int*)(lds + WSLOT_OFF))[HW_SLOT()] = tid0 >> 6;
        __syncthreads();
        if (!MK_PER_PHASE) { KArgs A = kargs(); (void)xcd_barrier_post((unsigned*)((gu32*)(A->ws + WS_CTL) + CW_BAR), (volatile LAS unsigned*)(lds + MISC_OFF) + 8, tid0); }
    }
#define PH_LOCALS \
    KArgs A = kargs(); unsigned char* ws = A->ws; (void)ws; \
    int tid_ = MY_TID(); asm volatile("" : "+v"(tid_)); const int tid = tid_, lane = tid & 63, wave = __builtin_amdgcn_readfirstlane(tid >> 6); (void)lane; (void)wave; \
    const int G = gridDim.x; const int bx = blockIdx.x; const int vcu = (G % 8 == 0) ? (bx % 8) * (G / 8) + bx / 8 : bx; (void)vcu; \
    const int gw = vcu * NWAVES + wave, NGW = G * NWAVES; (void)gw; (void)NGW;
#define IN(k) (kargs()->ph_lo <= (k) && (k) < kargs()->ph_hi)
#define SEAM(k) do { if (!MK_PER_PHASE && IN(k) && IN((k) + 1)) { KArgs A_ = kargs(); XcdBarrier bar_; bar_.bar = (unsigned*)((gu32*)(A_->ws + WS_CTL) + CW_BAR); bar_.x = xb_xcc_id(); \
        bar_.st = (volatile LAS unsigned*)(lds + MISC_OFF) + 8; xcd_barrier(bar_, MY_TID()); } } while (0)

    if (IN(0)) {
        PH_LOCALS
        convert_items(A, ws, lds, 0, lane, wave, gw, NGW, DEPTH * CI_SMALL);
        { const int* positions = (const int*)A->in[1]; float* CS = (float*)(ws + WS_CS);
          for (int idx = vcu * 512 + tid; idx < T * 8; idx += G * 512) { const int t = idx >> 3, i = idx & 7;
              double iv = 1.0;
              iv = (i == 1) ? 0.19392274474868576 : iv; iv = (i == 2) ? 0.03760603093086393 : iv; iv = (i == 3) ? 0.0072926647372171085 : iv; iv = (i == 4) ? 0.0014142135623730952 : iv;
              iv = (i == 5) ? 0.0002742481756762073 : iv; iv = (i == 6) ? 5.318295896944988e-05 : iv; iv = (i == 7) ? 1.0313385377212458e-05 : iv;
              float sn, cn; sincos_d((double)positions[t] * iv, sn, cn); CS[(size_t)t * 16 + i] = cn; CS[(size_t)t * 16 + 8 + i] = sn; } }
        { bf16* WR = (bf16*)(ws + WS_RW);
          for (int idx = vcu * 512 + tid; idx < DEPTH * 80 * D; idx += G * 512) { const int l = idx / (80 * D), rem = idx % (80 * D), n = rem / D, k = rem % D;
              float w = 0.f;
              if (n < 8) w = ((const float*)A->in[11])[((size_t)l * D + k) * 8 + n];
              else if (n < 72) { const int g = (n - 8) >> 3, e = (n - 8) & 7; w = ((const float*)A->in[13])[(((size_t)l * 8 + g) * D + k) * 8 + e]; }
              w *= ((const float*)A->in[10])[l * D + k];
              const unsigned hi = pg8::cvt_pk_bf16_c(w, 0.f) & 0xffffu; const float rest = w - __uint_as_float(hi << 16); const unsigned lo = pg8::cvt_pk_bf16_c(rest, 0.f) & 0xffffu;
              WR[((size_t)(l * 2 + 0) * 80 + n) * D + k] = (bf16)hi; WR[((size_t)(l * 2 + 1) * 80 + n) * D + k] = (bf16)lo; } }
        { const float* x = (const float*)A->in[0]; bf16* NB = (bf16*)(ws + WS_N); const float* g1 = (const float*)A->in[2];
          norm_rows<0>(lane, gw, NGW, x, nullptr, nullptr, g1, NB, (unsigned char*)(ws + WS_N8), nullptr); }
    }
    SEAM(0);

    auto layer_body = [&](auto lc_) { constexpr int l = decltype(lc_)::value;
        const int pb = 1 + l * PH_PER_LAYER;
        if (IN(pb + 0)) {
            PH_LOCALS
            bf16* HB = (bf16*)(ws + WS_H); const unsigned char* SLAB = (const unsigned char*)(ws + WS_U); bf16* NB = (bf16*)(ws + WS_N); const float* g1 = (const float*)A->in[2] + l * D;
            if (l > 0) norm_rows<1>(lane, gw, NGW, nullptr, HB, SLAB, g1, NB, (unsigned char*)(ws + WS_N8), nullptr);
        }
        if (l > 0) SEAM(pb + 0);
        if (IN(pb + 1)) {
            PH_LOCALS
            pg8::Gemm g{(bf16*)(ws + WS_N), (bf16*)(ws + WS_WIN) + (size_t)l * 3072 * D, nullptr}; pg8::StaticOrder<T, 3072> S; S.init(G, bx);
            pg8::EpiInProj<0> E{(bf16*)(ws + WS_U), (bf16*)(ws + WS_CC), (bf16*)(ws + WS_Q), (bf16*)(ws + WS_K), (bf16*)(ws + WS_VT), (bf16*)(ws + WS_G), (const float*)A->in[4] + l * 2048, (const float*)(ws + WS_CS), 1.0f};
            const bool few = (G == 256) && (bx >= 128); const int cfirst = (G == 256) ? (few ? 23552 + (bx - 128) * 8 + wave : bx * 8 + wave) : gw;
            const int cstride = (G == 256) ? 1024 : NGW; const int cend = (G == 256 && !few) ? 23552 : DEPTH * CI_EXP;
            if (l == 0 && (vcu & 1) == 0) { convert_items(A, ws, lds, 1, lane, wave, cfirst, cstride, cend); __syncthreads(); }
            pg8::gemm_phase<pg8::EpiInProj<0>, pg8::StaticOrder<T, 3072>, true, true, false, D>(lds + RING_OFF, tid, g, S, E, nullptr);
            { pg8::Gemm g8{(const pg8::bf16_t*)(ws + WS_N8), (const pg8::bf16_t*)(ws + WS_WIN8 + (size_t)l * 3328 * D), nullptr}; pg8::StaticOrder<T, 3328> S8; S8.init(G, bx);
              pg8::EpiInProj<1> E8{E.U, E.CC, E.Q, E.Kb, E.VT, E.G, E.bgate, E.cs, 1.0f / pg8::WIN8_SCALE};
              pg8::gemm_phase<pg8::EpiInProj<1>, pg8::StaticOrder<T, 3328>, true, true, false, D, false, true>(lds + RING_OFF, tid, g8, S8, E8, nullptr); }
        }
        if (IN(pb + 1) && l == 0) {
            PH_LOCALS
            if ((vcu & 1) == 1) {
                const bool few = (G == 256) && (bx >= 128); const int cfirst = (G == 256) ? (few ? 23552 + (bx - 128) * 8 + wave : bx * 8 + wave) : gw;
                const int cstride = (G == 256) ? 1024 : NGW; const int cend = (G == 256 && !few) ? 23552 : DEPTH * CI_EXP;
                convert_items(A, ws, lds, 1, lane, wave, cfirst, cstride, cend); __syncthreads(); }
        }
        SEAM(pb + 1);
        if (IN(pb + 2)) {
            PH_LOCALS
            const unsigned char* QB = (const unsigned char*)(ws + WS_Q); const bf16* KB = (const bf16*)(ws + WS_K); const bf16* VTB = (const bf16*)(ws + WS_VT);
            unsigned char* OB = (unsigned char*)(ws + WS_O8);
            const float* sinks = (const float*)A->in[6] + l * 16;
            attn_phase(lds, tid, vcu, G, QB, OB, KB, VTB, sinks);
            const float* cw = (const float*)A->in[5] + l * 3 * D;
            if (G == 256) { for (int k = 0; k < 2; ++k) conv_item(tid, (vcu >> 5) * 64 + (vcu & 31) + 32 * k, (const bf16*)(ws + WS_U), (const bf16*)(ws + WS_CC), cw, (bf16*)(ws + WS_N)); }
            else for (int it = vcu; it < T / 64; it += G) conv_item(tid, it, (const bf16*)(ws + WS_U), (const bf16*)(ws + WS_CC), cw, (bf16*)(ws + WS_N));
        }
        SEAM(pb + 2);
        if (IN(pb + 3)) {
            PH_LOCALS
            pg8::Gemm g{(bf16*)(ws + WS_N), (const pg8::bf16_t*)(ws + WS_WC + (size_t)l * D * 3072), (const pg8::bf16_t*)(ws + WS_O8)}; pg8::StaticOrder<T, D> S; S.init(G, bx);
            pg8::EpiGate2 E{(const unsigned char*)(ws + WS_G), (bf16*)(ws + WS_CC)};
            pg8::gemm_phase<pg8::EpiGate2, pg8::StaticOrder<T, D>, true, true, false, 2 * D, true, false, true>(lds + RING_OFF, tid, g, S, E, nullptr);
        }
        SEAM(pb + 4);
        if (IN(pb + 5)) {
            PH_LOCALS
            pg8::Gemm g{(bf16*)(ws + WS_CC), (bf16*)(ws + WS_WO) + (size_t)l * D * D, nullptr}; pg8::StaticOrder<T, D> S; S.init(G, bx);
            pg8::EpiResid E{(l == 0) ? (const float*)A->in[0] : nullptr, (const bf16*)(ws + WS_H), (bf16*)(ws + WS_H), (unsigned char*)(ws + WS_H8), (const float*)A->in[10] + l * D};
            pg8::gemm_phase<pg8::EpiResid, pg8::StaticOrder<T, D>, true, true, false, D>(lds + RING_OFF, tid, g, S, E, nullptr);
        }
        SEAM(pb + 5);
        if (IN(pb + 6)) {
            PH_LOCALS
            unsigned* cnt = (unsigned*)((gu32*)(ws + WS_CTL) + CW_CNT) + l * 64 * 16;
            const float* bg = (const float*)A->in[12] + l * 8; const float* brt = (const float*)A->in[14] + l * 64;
            const bf16* HB = (const bf16*)(ws + WS_H); int* LISTS = (int*)(ws + WS_LIST); float* WTS = (float*)(ws + WS_WTS);
            const bf16* WR = (const bf16*)(ws + WS_RW) + (size_t)l * 2 * 80 * D;
            for (int rb = vcu; rb < T / 128; rb += G) router_block(lds, tid, rb * 128, HB, WR, bg, brt, cnt, LISTS, WTS, (float*)(ws + WS_RSTD));
        }
        SEAM(pb + 6);
#define MOE_PTRS \
        LAS int* tstart = (LAS int*)(lds + TAB_OFF); LAS int* cntL = (LAS int*)(lds + TAB_OFF + 512); \
        LAS int* tokT = (LAS int*)(lds + TOK_OFF); LAS float* wtT = (LAS float*)(lds + WT_OFF); LAS int* tokA = (LAS int*)(lds + TOKA_OFF); LAS float* wtA = (LAS float*)(lds + WTA_OFF); \
        (void)cntL; (void)tokT; (void)wtT; (void)tokA; (void)wtA;
#define MOE_ORDER \
        pg8::MoeOrder S; S.NT4 = __builtin_amdgcn_readfirstlane(tstart[64] * 4); S.G = G; S.c = vcu; S.uexp = (LAS int*)(lds + TAB_OFF + 768);
#define MOE_BUILD \
        { unsigned* cnt = (unsigned*)((gu32*)(ws + WS_CTL) + CW_CNT) + l * 64 * 16; const int* LISTS = (const int*)(ws + WS_LIST); const float* WTS = (const float*)(ws + WS_WTS); const float* RSTD = (const float*)(ws + WS_RSTD); \
          if (tid < 64) { const int c_ = (int)__hip_atomic_load(cnt + tid * 16, RLX_AGENT); cntL[tid] = c_; const int v_ = (c_ + 255) >> 8; int inc_ = v_; \
              _Pragma("unroll") for (int d_ = 1; d_ < 64; d_ *= 2) { const int o_ = __builtin_amdgcn_ds_bpermute(((tid - d_) & 63) * 4, inc_); if (tid >= d_) inc_ += o_; } \
              tstart[tid] = inc_ - v_; if (tid == 63) tstart[64] = inc_; } \
          __syncthreads(); \
          if (tid < MAX_UNITS) { const int mt_ = (tid * G + vcu) >> 2; int e_ = 0; for (int k_ = 1; k_ < 64; ++k_) e_ += (tstart[k_] <= mt_) ? 1 : 0; ((LAS int*)(lds + TAB_OFF + 768))[tid] = e_; } \
          __syncthreads(); \
          MOE_ORDER \
          v4u entv[MAX_UNITS]; \
          _Pragma("unroll") for (int i = 0; i < MAX_UNITS; ++i) { entv[i] = (v4u){0xffffffffu, 0u, 0u, 0u}; pg8::Unit u; if (S.next(i, u) && tid < 256) { const int e = u.pn >> 2; const int idx = (u.pm - tstart[e]) * 256 + tid; \
              if (idx < cntL[e]) entv[i] = ((const GAS v4u*)LISTS)[(size_t)e * LIST_CAP + idx]; } } \
          _Pragma("unroll") for (int i = 0; i < MAX_UNITS; ++i) { if (i * G + vcu < S.NT4 && tid < 256) { const int aid = (int)entv[i].x; const bool valid = aid >= 0; \
              tokT[i * 256 + tid] = valid ? (aid >> 1) : 0; wtT[i * 256 + tid] = valid ? __uint_as_float(entv[i].z) : 0.f; tokA[i * 256 + tid] = aid; wtA[i * 256 + tid] = valid ? __uint_as_float(entv[i].y) : 0.f; } } \
          __syncthreads(); }
        if (IN(pb + 7)) {
            PH_LOCALS
            MOE_PTRS
            MOE_BUILD
            MOE_ORDER
            pg8::Gemm g{(const pg8::bf16_t*)(ws + WS_H8), (const pg8::bf16_t*)(ws + WS_W13 + (size_t)l * NEXP * 1024 * D), nullptr}; pg8::EpiFfn1 E{(unsigned char*)(ws + WS_G), wtT};
            pg8::gemm_phase<pg8::EpiFfn1, pg8::MoeOrder, true, true, true, D, false, true>(lds + RING_OFF, tid, g, S, E, tokT);
        }
        SEAM(pb + 7);
        if (IN(pb + 8)) {
            PH_LOCALS
            MOE_PTRS
            if (MK_PER_PHASE) MOE_BUILD
            MOE_ORDER
            pg8::Gemm g{(const pg8::bf16_t*)(ws + WS_G), (const pg8::bf16_t*)(ws + WS_W2 + (size_t)l * NEXP * D * FF), nullptr}; pg8::EpiFfn2 E{(unsigned char*)(ws + WS_U), tokA, wtA};
            pg8::gemm_phase<pg8::EpiFfn2, pg8::MoeOrder, true, true, false, FF, false, true>(lds + RING_OFF, tid, g, S, E, nullptr);
        }
        SEAM(pb + 8);
#undef MOE_PTRS
#undef MOE_ORDER
#undef MOE_BUILD
    };
    layer_body(LayerTag<0>{}); layer_body(LayerTag<1>{});
    static_assert(DEPTH == 2, "two layers");
    if (IN(N_PHASES - 1)) {
        PH_LOCALS
        bf16* HB = (bf16*)(ws + WS_H); const unsigned char* SLAB = (const unsigned char*)(ws + WS_U);
        norm_rows<2>(lane, gw, NGW, nullptr, HB, SLAB, (const float*)A->in[18], nullptr, nullptr, A->out);
    }
#undef IN
#undef SEAM
#undef PH_LOCALS
#undef MY_TID
#undef HW_SLOT
}

extern "C" void kernel_launch(void* const* d_in, const int* in_sizes, int n_in, void* d_out, int out_size, void* d_ws, size_t ws_size, hipStream_t stream) {
    static int grid = 0;
    if (grid == 0) {
        if (n_in != 19 || out_size != T * D || ws_size < WS_END) { fprintf(stderr, "kernel_launch: unexpected sizes n_in %d out %d ws %zu\n", n_in, out_size, ws_size); grid = -1; return; }
        int dev = 0, cus = 0;
        if (hipGetDevice(&dev) != hipSuccess || hipDeviceGetAttribute(&cus, hipDeviceAttributeMultiprocessorCount, dev) != hipSuccess) { grid = -1; return; }
        if (hipFuncSetAttribute((const void*)fwd_kernel, hipFuncAttributeMaxDynamicSharedMemorySize, LDS_BYTES) != hipSuccess) { fprintf(stderr, "kernel_launch: hipFuncSetAttribute failed\n"); grid = -1; return; }
        (void)hipGetLastError();
        grid = cus;
    }
    if (grid < 0) return;
    if (hipMemsetAsync((char*)d_ws + WS_CTL, 0, CTL_ZERO_BYTES, stream) != hipSuccess) return;
    Args a{};
    for (int i = 0; i < 19; ++i) a.in[i] = d_in[i];
    a.out = (float*)d_out; a.ws = (unsigned char*)d_ws;
#if MK_PER_PHASE
    for (int p = 0; p < N_PHASES; ++p) { a.ph_lo = p; a.ph_hi = p + 1; hipLaunchKernelGGL(fwd_kernel, dim3(grid), dim3(NWAVES * 64), LDS_BYTES, stream, a); }

#else
    a.ph_lo = 0; a.ph_hi = N_PHASES;
    hipLaunchKernelGGL(fwd_kernel, dim3(grid), dim3(NWAVES * 64), LDS_BYTES, stream, a);
#endif
}
```

```cpp
#include <hip/hip_runtime.h>
#include <cstdio>
#include <cstdint>

#ifndef MK_PER_PHASE
#define MK_PER_PHASE 0
#endif

constexpr int BATCH = 4, SEQ = 8192, D = 1024, T = BATCH * SEQ, DEPTH = 2;
constexpr int IN_COLS = 6400, NKV = 2, HD = 64, CHUNK = 64;
constexpr int NEXP = 64, FF = 512;
constexpr float RMS_EPS = 1e-5f;
constexpr float C2 = 0.125f * 1.4426950408889634f;
constexpr float LOG2E = 1.4426950408889634f;
constexpr int LIST_CAP = T;
constexpr int MAX_UNITS = 6;

namespace pg8 {
#define PG8_LAS __attribute__((address_space(3)))
typedef unsigned short bf16_t;
typedef short bf16x8 __attribute__((ext_vector_type(8)));
typedef float f32x4 __attribute__((ext_vector_type(4)));
typedef unsigned u32x4 __attribute__((ext_vector_type(4)));
typedef unsigned u32x2 __attribute__((ext_vector_type(2)));
typedef int v4i32 __attribute__((ext_vector_type(4)));
constexpr int BM = 256, BK = 64, HALF = 128, HTB = HALF * BK * 2, STAGE_BYTES = 8 * HTB, NXCD = 8, WGM = 8;

__host__ __device__ __forceinline__ int lds_byte(int r, int c) { const int st = (r >> 4) * 2 + (c >> 5), rr = r & 15, cc = c & 31, ob = rr * 64 + cc * 2; return st * 1024 + (ob ^ (((ob >> 9) & 1) << 5)); }
__host__ __device__ __forceinline__ void stage_rc(int b, int& R, int& C) { const int st = b / 1024, sb = b % 1024, swz = sb ^ (((sb >> 9) & 1) << 5); R = (st >> 1) * 16 + swz / 64; C = (st & 1) * 32 + (swz % 64) / 2; }
__host__ __device__ __forceinline__ int perm32(int rho) { const int n = rho >> 4, i = rho & 15; return 8 * (i >> 2) + 4 * n + (i & 3); }

__device__ __forceinline__ int lane_volatile() { int l; asm volatile("v_mbcnt_lo_u32_b32 %0, -1, 0\n\tv_mbcnt_hi_u32_b32 %0, -1, %0" : "=v"(l)); return l; }
struct Unit { int pm, pn; };
struct Gemm { const bf16_t* A; const bf16_t* Bt; const bf16_t* A2; };

template <int M_, int N_> struct StaticOrder {
    static constexpr int nM = M_ / BM, nN = N_ / BM, nwg = nM * nN; int G, c;
    __host__ __device__ void init(int G_, int c_) { G = G_; c = c_; }
    __host__ __device__ bool next(int i, Unit& u) const {
        const long L = (long)i * G + c; if (L >= nwg) return false;
        int wgid = (int)L; { const int q = nwg / NXCD, r = nwg % NXCD, xcd = wgid % NXCD, off = wgid / NXCD; wgid = (xcd < r ? xcd * (q + 1) : r * (q + 1) + (xcd - r) * q) + off; }
        const int nig = WGM * nN, gid = wgid / nig, fm = gid * WGM, gsz = (nM - fm) < WGM ? (nM - fm) : WGM;
        u.pm = fm + ((wgid % nig) % gsz); u.pn = (wgid % nig) / gsz; return true;
    }
};
struct MoeOrder {
    int NT4, G, c; const PG8_LAS int* uexp;
    __device__ __forceinline__ bool next(int i, Unit& u) const {
        const int L = i * G + c; if (L >= NT4) return false;
        u.pm = L >> 2; u.pn = __builtin_amdgcn_readfirstlane(uexp[i]) * 4 + (L & 3); return true;
    }
};

typedef float f32x2_t __attribute__((ext_vector_type(2))); typedef __bf16 bf16x2_t __attribute__((ext_vector_type(2)));
__device__ __forceinline__ unsigned cvt_pk_bf16(float lo, float hi) { unsigned r; asm volatile("s_nop 0\n\tv_cvt_pk_bf16_f32 %0, %1, %2" : "=v"(r) : "v"(lo), "v"(hi)); return r; }
__device__ __forceinline__ unsigned cvt_pk_bf16_c(float lo, float hi) { f32x2_t v = {lo, hi}; bf16x2_t b = __builtin_convertvector(v, bf16x2_t); return __builtin_bit_cast(unsigned, b); }
__device__ __forceinline__ float bf_lo(unsigned w) { return __uint_as_float(w << 16); }
__device__ __forceinline__ float bf_hi(unsigned w) { return __uint_as_float(w & 0xffff0000u); }
__device__ __forceinline__ u32x2 pack8_f8(const f32x4 a, const f32x4 b) { int w0 = __builtin_bit_cast(int, a[0]), w1 = __builtin_bit_cast(int, b[0]);
    w0 = __builtin_amdgcn_cvt_pk_fp8_f32(a[0], a[1], w0, false); w0 = __builtin_amdgcn_cvt_pk_fp8_f32(a[2], a[3], w0, true);
    w1 = __builtin_amdgcn_cvt_pk_fp8_f32(b[0], b[1], w1, false); w1 = __builtin_amdgcn_cvt_pk_fp8_f32(b[2], b[3], w1, true);
    u32x2 r; r.x = (unsigned)w0; r.y = (unsigned)w1; return r; }
constexpr float W13_SCALE = 32.0f, W2_SCALE = 16.0f, SLAB_SCALE = 16.0f, WA_SCALE = 32.0f, WIN8_SCALE = 32.0f, Q8_SCALE = 8.0f;
__device__ __forceinline__ u32x4 pack8c(const f32x4 a, const f32x4 b) { u32x4 w; w.x = cvt_pk_bf16_c(a[0], a[1]); w.y = cvt_pk_bf16_c(a[2], a[3]); w.z = cvt_pk_bf16_c(b[0], b[1]); w.w = cvt_pk_bf16_c(b[2], b[3]); return w; }
__device__ __forceinline__ u32x4 pack8(const f32x4 a, const f32x4 b) { u32x4 w; w.x = cvt_pk_bf16(a[0], a[1]); w.y = cvt_pk_bf16(a[2], a[3]); w.z = cvt_pk_bf16(b[0], b[1]); w.w = cvt_pk_bf16(b[2], b[3]); return w; }

typedef unsigned bu32x4_t __attribute__((__vector_size__(16))); typedef unsigned bu32x2_t __attribute__((__vector_size__(8)));
typedef f32x4 Acc[2][2][4][2];
__device__ __forceinline__ f32x4 zero4_asm() { float a, b, c, d; asm volatile("v_mov_b32 %0, 0\n\tv_mov_b32 %1, 0\n\tv_mov_b32 %2, 0\n\tv_mov_b32 %3, 0" : "=v"(a), "=v"(b), "=v"(c), "=v"(d)); return (f32x4){a, b, c, d}; }

template <int MODE> struct EpiInProj {
    bf16_t *U, *CC, *Q, *Kb, *VT, *G; const float* bgate; const float* cs; float sc;
    __device__ __forceinline__ void operator()(const Acc& acc, const Unit& u, int ui, int wr, int wc, int fr, int fq) const {
        const int pn = MODE ? 12 + u.pn : u.pn; const int row0 = u.pm * BM + wr * 64 + fr; const int cw = wc * 32 + 8 * fq;
        if (MODE == 0 && pn < 8) {
#pragma unroll
            for (int ai = 0; ai < 2; ++ai)
#pragma unroll
                for (int m = 0; m < 4; ++m) { const size_t row = row0 + ai * HALF + m * 16;
                    *(u32x4*)(U + row * D + pn * 128 + cw) = pack8(acc[ai][0][m][0] * acc[ai][1][m][0], acc[ai][0][m][1] * acc[ai][1][m][1]); }
        } else if (MODE == 0) {
#pragma unroll
            for (int ai = 0; ai < 2; ++ai)
#pragma unroll
                for (int m = 0; m < 4; ++m) { const size_t row = row0 + ai * HALF + m * 16;
#pragma unroll
                    for (int bj = 0; bj < 2; ++bj) *(u32x4*)(CC + row * D + (pn - 8) * 256 + bj * HALF + cw) = pack8c(acc[ai][bj][m][0], acc[ai][bj][m][1]); }
        } else if (pn < 16) {
            const bool rot = ((wc & 1) == 0) && (fq < 2);
#pragma unroll
            for (int ai = 0; ai < 2; ++ai) {
                f32x4 cv[4], sv[4];
#pragma unroll
                for (int m = 0; m < 4; ++m) { cv[m] = (f32x4){1.f, 1.f, 1.f, 1.f}; sv[m] = (f32x4){0.f, 0.f, 0.f, 0.f}; }
                if (rot) {
#pragma unroll
                    for (int m = 0; m < 4; ++m) { const size_t row = row0 + ai * HALF + m * 16; cv[m] = *(const f32x4*)(cs + row * 16 + 4 * fq); sv[m] = *(const f32x4*)(cs + row * 16 + 8 + 4 * fq); } }
#pragma unroll
                for (int m = 0; m < 4; ++m) { const size_t row = row0 + ai * HALF + m * 16;
                    const f32x4 c4 = cv[m], s4 = sv[m];
#pragma unroll
                    for (int bj = 0; bj < 2; ++bj) { f32x4 a = acc[ai][bj][m][0] * sc, b = acc[ai][bj][m][1] * sc;
                        f32x4 ra = {a[0] * c4[0] - a[1] * s4[0], a[1] * c4[0] + a[0] * s4[0], a[2] * c4[1] - a[3] * s4[1], a[3] * c4[1] + a[2] * s4[1]};
                        f32x4 rb = {b[0] * c4[2] - b[1] * s4[2], b[1] * c4[2] + b[0] * s4[2], b[2] * c4[3] - b[3] * s4[3], b[3] * c4[3] + b[2] * s4[3]};
                        *(u32x2*)((unsigned char*)Q + row * D + (pn - 12) * 256 + bj * HALF + cw) = pack8_f8(ra * (C2 * Q8_SCALE), rb * (C2 * Q8_SCALE)); }
                    asm volatile("" ::: "memory"); __builtin_amdgcn_sched_barrier(0); } }
        } else if (pn == 16) {
            const bool rot = ((wc & 1) == 0) && (fq < 2);
#pragma unroll
            for (int ai = 0; ai < 2; ++ai) {
                f32x4 cv[4], sv[4];
#pragma unroll
                for (int m = 0; m < 4; ++m) { cv[m] = (f32x4){1.f, 1.f, 1.f, 1.f}; sv[m] = (f32x4){0.f, 0.f, 0.f, 0.f}; }
                if (rot) {
#pragma unroll
                    for (int m = 0; m < 4; ++m) { const size_t row = row0 + ai * HALF + m * 16; cv[m] = *(const f32x4*)(cs + row * 16 + 4 * fq); sv[m] = *(const f32x4*)(cs + row * 16 + 8 + 4 * fq); } }
#pragma unroll
                for (int m = 0; m < 4; ++m) { const size_t row = row0 + ai * HALF + m * 16;
                    const f32x4 c4 = cv[m], s4 = sv[m];
                    { f32x4 a = acc[ai][0][m][0] * sc, b = acc[ai][0][m][1] * sc;
                      f32x4 ra = {a[0] * c4[0] - a[1] * s4[0], a[1] * c4[0] + a[0] * s4[0], a[2] * c4[1] - a[3] * s4[1], a[3] * c4[1] + a[2] * s4[1]};
                      f32x4 rb = {b[0] * c4[2] - b[1] * s4[2], b[1] * c4[2] + b[0] * s4[2], b[2] * c4[3] - b[3] * s4[3], b[3] * c4[3] + b[2] * s4[3]};
                      *(u32x4*)(Kb + row * 128 + cw) = pack8(ra, rb); }
                    { const int b_ = (int)(row >> 13), s_ = (int)(row & 8191); const int kh = wc >> 1, d0 = 32 * (wc & 1) + 8 * fq;
                      bf16_t* vp = VT + ((size_t)((b_ * 2 + kh) * 64 + d0)) * SEQ + s_;
#pragma unroll
                      for (int n = 0; n < 2; ++n)
#pragma unroll
                          for (int j = 0; j < 4; ++j) { const unsigned w = cvt_pk_bf16_c(acc[ai][1][m][n][j] * sc, 0.f); vp[(size_t)(4 * n + j) * SEQ] = (bf16_t)(w & 0xffffu); } } } }
        } else {
            const int gc0 = (pn - 17) * 256 + cw;
            f32x4 bv[2][2];
#pragma unroll
            for (int bj = 0; bj < 2; ++bj)
#pragma unroll
                for (int n = 0; n < 2; ++n) bv[bj][n] = *(const f32x4*)(bgate + gc0 + bj * HALF + 4 * n);
#pragma unroll
            for (int ai = 0; ai < 2; ++ai)
#pragma unroll
                for (int m = 0; m < 4; ++m) { const size_t row = row0 + ai * HALF + m * 16;
#pragma unroll
                    for (int bj = 0; bj < 2; ++bj) { f32x4 v[2];
#pragma unroll
                        for (int n = 0; n < 2; ++n) { const f32x4 x = acc[ai][bj][m][n] * sc + bv[bj][n];
#pragma unroll
                            for (int j = 0; j < 4; ++j) v[n][j] = __builtin_rintf(255.0f * __builtin_amdgcn_rcpf(1.0f + __builtin_amdgcn_exp2f(-LOG2E * x[j]))); }
                        u32x2 w; w.x = 0u; w.y = 0u;
#pragma unroll
                        for (int j = 0; j < 4; ++j) { w.x = __builtin_amdgcn_cvt_pk_u8_f32(v[0][j], j, w.x); w.y = __builtin_amdgcn_cvt_pk_u8_f32(v[1][j], j, w.y); }
                        *(u32x2*)((unsigned char*)G + row * 2048 + gc0 + bj * HALF) = w; } }
        }
    }
};
template <bool ADD> struct EpiGate {
    const bf16_t* G; int gcol0; const bf16_t* addend; bf16_t* O;
    __device__ __forceinline__ void operator()(const Acc& acc, const Unit& u, int ui, int wr, int wc, int fr, int fq) const {
        const int row0 = u.pm * BM + wr * 64 + fr; const int col0 = u.pn * BM + wc * 32 + 8 * fq;
#pragma unroll
        for (int ai = 0; ai < 2; ++ai) {
            u32x2 gv[4][2]; u32x4 tv[4][2];
#pragma unroll
            for (int m = 0; m < 4; ++m)
#pragma unroll
                for (int bj = 0; bj < 2; ++bj) { const size_t row = row0 + ai * HALF + m * 16; const int col = col0 + bj * HALF;
                    gv[m][bj] = *(const u32x2*)((const unsigned char*)G + row * 2048 + gcol0 + col);
                    if (ADD) tv[m][bj] = *(const u32x4*)(addend + row * D + col); }
#pragma unroll
            for (int m = 0; m < 4; ++m)
#pragma unroll
                for (int bj = 0; bj < 2; ++bj) { const size_t row = row0 + ai * HALF + m * 16; const int col = col0 + bj * HALF;
                    const u32x2 g = gv[m][bj]; constexpr float Q = 1.0f / 255.0f;
                    f32x4 a = acc[ai][bj][m][0], b = acc[ai][bj][m][1];
                    a = a * ((f32x4){(float)(g.x & 0xffu), (float)((g.x >> 8) & 0xffu), (float)((g.x >> 16) & 0xffu), (float)(g.x >> 24)} * Q);
                    b = b * ((f32x4){(float)(g.y & 0xffu), (float)((g.y >> 8) & 0xffu), (float)((g.y >> 16) & 0xffu), (float)(g.y >> 24)} * Q);
                    if (ADD) { const u32x4 t = tv[m][bj];
                        a = a + (f32x4){bf_lo(t.x), bf_hi(t.x), bf_lo(t.y), bf_hi(t.y)}; b = b + (f32x4){bf_lo(t.z), bf_hi(t.z), bf_lo(t.w), bf_hi(t.w)}; }
                    *(u32x4*)(O + row * D + col) = pack8(a, b); }
        }
    }
};
struct EpiGate2 {
    const unsigned char* G8; bf16_t* O;
    __device__ __forceinline__ void mid(Acc& acc, const Unit& u, int wr, int wc, int fr, int fq) const {
        const auto rG = __builtin_amdgcn_make_buffer_rsrc((void*)G8, 0, 0xffffffff, 0x00020000);
        int vo = (u.pm * BM + wr * 64 + fr) * 2048 + u.pn * BM + wc * 32 + 8 * fq;
        asm volatile("" : "+v"(vo) :: "memory");
#pragma unroll
        for (int ai = 0; ai < 2; ++ai) {
            u32x2 gc[4][2], ga[4][2];
#pragma unroll
            for (int m = 0; m < 4; ++m)
#pragma unroll
                for (int bj = 0; bj < 2; ++bj) {
                    gc[m][bj] = __builtin_bit_cast(u32x2, __builtin_amdgcn_raw_buffer_load_b64(rG, vo + bj * HALF, (ai * HALF + m * 16) * 2048, 0));
                    ga[m][bj] = __builtin_bit_cast(u32x2, __builtin_amdgcn_raw_buffer_load_b64(rG, vo + bj * HALF + 1024, (ai * HALF + m * 16) * 2048, 0)); }
#pragma unroll
            for (int m = 0; m < 4; ++m)
#pragma unroll
                for (int bj = 0; bj < 2; ++bj)
#pragma unroll
                    for (int n = 0; n < 2; ++n) { const unsigned c = n ? gc[m][bj].y : gc[m][bj].x, a = n ? ga[m][bj].y : ga[m][bj].x;
#pragma unroll
                        for (int j = 0; j < 4; ++j) { const float qc = (float)((c >> (8 * j)) & 0xffu), qa = fmaxf((float)((a >> (8 * j)) & 0xffu), 1.0f);
                            acc[ai][bj][m][n][j] *= (WA_SCALE * qc) * __builtin_amdgcn_rcpf(qa); } }
            asm volatile("" ::: "memory"); __builtin_amdgcn_sched_barrier(0);
        }
    }
    __device__ __forceinline__ void operator()(const Acc& acc, const Unit& u, int ui, int wr, int wc, int fr, int fq) const {
        const auto rG = __builtin_amdgcn_make_buffer_rsrc((void*)G8, 0, 0xffffffff, 0x00020000);
        int row0 = u.pm * BM + wr * 64 + fr; const int col0 = u.pn * BM + wc * 32 + 8 * fq;
        asm volatile("" : "+v"(row0));
        const int vo = row0 * 2048 + col0 + 1024;
        u32x2 ga[2][4][2];
#pragma unroll
        for (int ai = 0; ai < 2; ++ai)
#pragma unroll
            for (int m = 0; m < 4; ++m)
#pragma unroll
                for (int bj = 0; bj < 2; ++bj) ga[ai][m][bj] = __builtin_bit_cast(u32x2, __builtin_amdgcn_raw_buffer_load_b64(rG, vo + bj * HALF, (ai * HALF + m * 16) * 2048, 0));
#pragma unroll
        for (int ai = 0; ai < 2; ++ai)
#pragma unroll
            for (int m = 0; m < 4; ++m)
#pragma unroll
                for (int bj = 0; bj < 2; ++bj) { const u32x2 g = ga[ai][m][bj]; constexpr float Q = 1.0f / (255.0f * WA_SCALE); f32x4 v[2];
#pragma unroll
                    for (int n = 0; n < 2; ++n) { const unsigned a = n ? g.y : g.x;
#pragma unroll
                        for (int j = 0; j < 4; ++j) v[n][j] = acc[ai][bj][m][n][j] * (fmaxf((float)((a >> (8 * j)) & 0xffu), 1.0f) * Q); }
                    *(u32x4*)(O + (size_t)(row0 + ai * HALF + m * 16) * D + col0 + bj * HALF) = pack8(v[0], v[1]); }
    }
};
struct EpiResid {
    const float* Xin; const bf16_t* Hin16; bf16_t* Hout; unsigned char* H8;
    __device__ __forceinline__ void operator()(const Acc& acc, const Unit& u, int ui, int wr, int wc, int fr, int fq) const {
        const int row0 = u.pm * BM + wr * 64 + fr; const int col0 = u.pn * BM + wc * 32 + 8 * fq;
        if (Xin) {
#pragma unroll
            for (int ai = 0; ai < 2; ++ai)
#pragma unroll
                for (int mh = 0; mh < 2; ++mh) {
                    f32x4 hv[2][2][2];
#pragma unroll
                    for (int mm = 0; mm < 2; ++mm)
#pragma unroll
                        for (int bj = 0; bj < 2; ++bj) { const size_t o = (size_t)(row0 + ai * HALF + (2 * mh + mm) * 16) * D + col0 + bj * HALF;
                            hv[mm][bj][0] = *(const f32x4*)(Xin + o); hv[mm][bj][1] = *(const f32x4*)(Xin + o + 4); }
#pragma unroll
                    for (int mm = 0; mm < 2; ++mm)
#pragma unroll
                        for (int bj = 0; bj < 2; ++bj) { const int m = 2 * mh + mm; const size_t o = (size_t)(row0 + ai * HALF + m * 16) * D + col0 + bj * HALF;
                            const f32x4 r0 = hv[mm][bj][0] + acc[ai][bj][m][0], r1 = hv[mm][bj][1] + acc[ai][bj][m][1];
                            *(u32x4*)(Hout + o) = pack8(r0, r1); *(u32x2*)(H8 + o) = pack8_f8(r0, r1); }
                }
        } else {
#pragma unroll
            for (int ai = 0; ai < 2; ++ai) {
                u32x4 hv[4][2];
#pragma unroll
                for (int m = 0; m < 4; ++m)
#pragma unroll
                    for (int bj = 0; bj < 2; ++bj) hv[m][bj] = *(const u32x4*)(Hin16 + (size_t)(row0 + ai * HALF + m * 16) * D + col0 + bj * HALF);
#pragma unroll
                for (int m = 0; m < 4; ++m)
#pragma unroll
                    for (int bj = 0; bj < 2; ++bj) { const size_t o = (size_t)(row0 + ai * HALF + m * 16) * D + col0 + bj * HALF; const u32x4 t = hv[m][bj];
                        const f32x4 r0 = (f32x4){bf_lo(t.x), bf_hi(t.x), bf_lo(t.y), bf_hi(t.y)} + acc[ai][bj][m][0], r1 = (f32x4){bf_lo(t.z), bf_hi(t.z), bf_lo(t.w), bf_hi(t.w)} + acc[ai][bj][m][1];
                        *(u32x4*)(Hout + o) = pack8(r0, r1); *(u32x2*)(H8 + o) = pack8_f8(r0, r1); }
            }
        }
    }
};
struct EpiFfn1 {
    unsigned char* HID8; const PG8_LAS float* rs;
    __device__ __forceinline__ void operator()(const Acc& acc, const Unit& u, int ui, int wr, int wc, int fr, int fq) const {
        const int row0 = u.pm * BM + wr * 64 + fr; const int col0 = (u.pn & 3) * 128 + wc * 32 + 8 * fq;
#pragma unroll
        for (int ai = 0; ai < 2; ++ai)
#pragma unroll
            for (int m = 0; m < 4; ++m) { const size_t row = row0 + ai * HALF + m * 16; f32x4 v[2]; const float r = rs[ui * 256 + ai * HALF + wr * 64 + m * 16 + fr] * (1.0f / W13_SCALE);
#pragma unroll
                for (int n = 0; n < 2; ++n)
#pragma unroll
                    for (int j = 0; j < 4; ++j) { const float x = acc[ai][0][m][n][j] * r; v[n][j] = x * __builtin_amdgcn_rcpf(1.0f + __builtin_amdgcn_exp2f(-LOG2E * x)) * (acc[ai][1][m][n][j] * r); }
                *(u32x2*)(HID8 + row * FF + col0) = pack8_f8(v[0], v[1]); }
    }
};
struct EpiFfn2 {
    unsigned char* SLAB; const PG8_LAS int* aid; const PG8_LAS float* wt;
    __device__ __forceinline__ void operator()(const Acc& acc, const Unit& u, int ui, int wr, int wc, int fr, int fq) const {
        const int col0 = (u.pn & 3) * BM + wc * 32 + 8 * fq;
#pragma unroll
        for (int ai = 0; ai < 2; ++ai)
#pragma unroll
            for (int m = 0; m < 4; ++m) { const int rl = ai * HALF + wr * 64 + m * 16 + fr; const int a = aid[ui * 256 + rl]; const float w = wt[ui * 256 + rl] * (SLAB_SCALE / W2_SCALE);
                if (a >= 0) {
#pragma unroll
                    for (int bj = 0; bj < 2; ++bj) *(u32x2*)(SLAB + (size_t)a * D + col0 + bj * HALF) = pack8_f8(acc[ai][bj][m][0] * w, acc[ai][bj][m][1] * w); } }
    }
};

template <class Epi, class Sched, bool ALIGN_EPI, bool SP2, bool GATHER, int KDIM, bool DUALA = false, bool F8 = false, bool MIXED = false>
__device__ __forceinline__ void gemm_phase(PG8_LAS unsigned char* lds, const int tid, const Gemm g, const Sched& S, const Epi& E, const PG8_LAS int* tokTab) {
    static_assert(SP2 && (!MIXED || (DUALA && !F8 && !GATHER)), "two super-phases per K-tile; MIXED needs DUALA");
    const int wid = __builtin_amdgcn_readfirstlane(tid >> 6), lane = tid & 63, wr = wid >> 2, wc = wid & 3, fr = lane & 15, fq = lane >> 4;
    constexpr int ESZ = F8 ? 1 : 2, K = KDIM, NTB = 16, nt = MIXED ? 24 : K * ESZ / 128, MIDT = MIXED ? NTB : nt / 2;
    constexpr unsigned AROW = MIXED ? 2048u : (unsigned)((DUALA ? K / 2 : K) * ESZ), AROWF = 1024u, BROW = MIXED ? 3072u : (unsigned)(K * ESZ);
    unsigned voffA[2], voffAF[2], voffB[2];
#pragma unroll
    for (int i = 0; i < 2; ++i) { int R, C; stage_rc(tid * 16 + i * 8192, R, C); const int Rb = (R & ~31) + perm32(R & 31);
        voffA[i] = (unsigned)R * AROW + (unsigned)(C * 2); voffAF[i] = (unsigned)R * AROWF + (unsigned)(C * 2); voffB[i] = (unsigned)Rb * BROW + (unsigned)(C * 2); }
    constexpr unsigned kstep = (unsigned)(BK * 2);
    constexpr unsigned hstep = (unsigned)HALF * BROW, tstep = 2 * hstep;
    constexpr unsigned hstepA = (unsigned)HALF * AROW, tstepA = 2 * hstepA, hstepAF = (unsigned)HALF * AROWF, tstepAF = 2 * hstepAF;
    const unsigned ldsw = (unsigned)wid * 1024u;
    const int aoffB = lds_byte(wr * 64 + fr, fq * 8), boffB = lds_byte(wc * 32 + fr, fq * 8);
    const int aoffF = lds_byte(wr * 64 + fr, (fq & 1) * 16) + (fq >> 1) * 1024, boffF = lds_byte(wc * 32 + fr, (fq & 1) * 16) + (fq >> 1) * 1024;
    unsigned gA[2][2];
    const auto rA = __builtin_amdgcn_make_buffer_rsrc((void*)g.A, 0, 0xffffffff, 0x00020000);
    const auto rB = __builtin_amdgcn_make_buffer_rsrc((void*)g.Bt, 0, 0xffffffff, 0x00020000);
    const unsigned dA2 = DUALA ? (unsigned)((const char*)g.A2 - (const char*)g.A) : 0u;
#define PG8_SA(b, h) (((b) * 2 + (h)) * HTB)
#define PG8_SB(b, h) ((4 + (b) * 2 + (h)) * HTB)
#define PG8_DMA(rsrc, vo, so, ldsoff) __builtin_amdgcn_raw_ptr_buffer_load_lds(rsrc, (PG8_LAS unsigned*)(lds + (ldsoff)), 16, (vo), (so), 0, 0)
#define PG8_STAGE_B(bufoff, so) do { _Pragma("unroll") for (int _i = 0; _i < 2; ++_i) PG8_DMA(rB, voffB[_i], (so), (bufoff) + ldsw + _i * 8192); } while (0)
#define PG8_STAGE_A(bufoff, so, h, isf) do { _Pragma("unroll") for (int _i = 0; _i < 2; ++_i) { \
        if constexpr (GATHER) PG8_DMA(rA, gA[h][_i], (so), (bufoff) + ldsw + _i * 8192); \
        else if constexpr (MIXED) PG8_DMA(rA, (isf) ? voffAF[_i] : voffA[_i], (so) + (h) * ((isf) ? hstepAF : hstepA), (bufoff) + ldsw + _i * 8192); \
        else PG8_DMA(rA, voffA[_i], (so) + (h) * hstepA, (bufoff) + ldsw + _i * 8192); } } while (0)
#define PG8_LDA(dst, b, h, FX) do { _Pragma("unroll") for (int m = 0; m < 4; ++m) _Pragma("unroll") for (int k = 0; k < 2; ++k) dst[m][k] = *(const PG8_LAS bf16x8*)(lds + PG8_SA(b, h) + ((FX) ? aoffF : aoffB) + m * 2048 + k * ((FX) ? 16 : 1024)); } while (0)
#define PG8_LDB(dst, b, h, FX) do { _Pragma("unroll") for (int n = 0; n < 2; ++n) _Pragma("unroll") for (int k = 0; k < 2; ++k) dst[n][k] = *(const PG8_LAS bf16x8*)(lds + PG8_SB(b, h) + ((FX) ? boffF : boffB) + n * 2048 + k * ((FX) ? 16 : 1024)); } while (0)
#define PG8_F8OP(x) __builtin_shufflevector(__builtin_bit_cast(v4i32, x[0]), __builtin_bit_cast(v4i32, x[1]), 0, 1, 2, 3, 4, 5, 6, 7)
#define PG8_MMA(ai, bj, At, Bt, FX) do { __builtin_amdgcn_s_setprio(1); _Pragma("unroll") for (int m = 0; m < 4; ++m) _Pragma("unroll") for (int n = 0; n < 2; ++n) { \
        if constexpr (FX) acc[ai][bj][m][n] = __builtin_amdgcn_mfma_scale_f32_16x16x128_f8f6f4(PG8_F8OP(Bt[n]), PG8_F8OP(At[m]), acc[ai][bj][m][n], 0, 0, 0, 0x7f7f7f7f, 0, 0x7f7f7f7f); \
        else { _Pragma("unroll") for (int k = 0; k < 2; ++k) acc[ai][bj][m][n] = __builtin_amdgcn_mfma_f32_16x16x32_bf16(Bt[n][k], At[m][k], acc[ai][bj][m][n], 0, 0, 0); } } \
        __builtin_amdgcn_s_setprio(0); } while (0)
#define PG8_WAIT_V(n) asm volatile("s_waitcnt vmcnt(" #n ")" ::: "memory")
#define PG8_WAIT_L(n) asm volatile("s_waitcnt lgkmcnt(" #n ")" ::: "memory")
#define PG8_BAR __builtin_amdgcn_s_barrier()
#define PG8_SCHED __builtin_amdgcn_sched_barrier(0)
#define PG8_GLOAD(dst, ui_) do { int _R, _C; stage_rc(tid * 16, _R, _C); _Pragma("unroll") for (int _h = 0; _h < 2; ++_h) _Pragma("unroll") for (int _i = 0; _i < 2; ++_i) \
        dst[_h][_i] = (unsigned)tokTab[(ui_) * 256 + _h * HALF + _R + 64 * _i] * (unsigned)(K * ESZ) + (unsigned)(_C * 2); } while (0)
    Unit cur, nxt; int ui = 0;
    if (!S.next(0, cur)) return;
    f32x4 acc[2][2][4][2];
#pragma unroll
    for (int a = 0; a < 2; ++a)
#pragma unroll
        for (int b = 0; b < 2; ++b)
#pragma unroll
            for (int m = 0; m < 4; ++m)
#pragma unroll
                for (int n = 0; n < 2; ++n) { acc[a][b][m][n] = zero4_asm(); }
    bf16x8 At[4][2], B0[2][2], B1[2][2];
    unsigned cA = GATHER ? 0u : (unsigned)cur.pm * tstepA, cB = (unsigned)cur.pn * tstep;
    unsigned cA2 = DUALA ? dA2 + (unsigned)cur.pm * (MIXED ? tstepAF : tstepA) : 0u;
#define PG8_AOFF(kt) ((DUALA && (kt) >= MIDT) ? cA2 + (unsigned)((kt) - MIDT) * kstep : cA + (unsigned)(kt) * kstep)
    if constexpr (GATHER) { PG8_GLOAD(gA, 0); }
    PG8_STAGE_B(PG8_SB(0, 0), cB); PG8_STAGE_B(PG8_SB(0, 1), cB + hstep); PG8_STAGE_A(PG8_SA(0, 0), cA, 0, false); PG8_STAGE_A(PG8_SA(0, 1), cA, 1, false);
    if (wr == 1) PG8_BAR;
    PG8_WAIT_V(2); PG8_BAR;
    PG8_STAGE_B(PG8_SB(1, 0), cB + kstep); PG8_STAGE_A(PG8_SA(1, 0), cA + kstep, 0, false); PG8_STAGE_B(PG8_SB(1, 1), cB + hstep + kstep);
    PG8_WAIT_V(6); PG8_BAR;
    for (;;) {
        const bool has_next = S.next(ui + 1, nxt);
        const unsigned nA = GATHER ? 0u : (has_next ? (unsigned)nxt.pm * tstepA : cA), nB = has_next ? (unsigned)nxt.pn * tstep : cB;
        const unsigned nA2 = DUALA ? (has_next ? dA2 + (unsigned)nxt.pm * (MIXED ? tstepAF : tstepA) : cA2) : 0u;
#define PG8_TRIP(FX) do { \
            PG8_LDB(B0, 0, 0, FX); PG8_LDB(B1, 0, 1, FX); PG8_SCHED; PG8_LDA(At, 0, 0, FX); PG8_STAGE_A(PG8_SA(1, 1), a1, 1, f1); \
            if constexpr (GATHER) { if (last && has_next) { PG8_GLOAD(gA, ui + 1); } } \
            PG8_WAIT_V(8); PG8_WAIT_L(0); PG8_BAR; PG8_MMA(0, 0, At, B0, FX); PG8_MMA(0, 1, At, B1, FX); PG8_BAR; PG8_SCHED; \
            PG8_LDA(At, 0, 1, FX); PG8_STAGE_B(PG8_SB(0, 0), b2); PG8_STAGE_B(PG8_SB(0, 1), b2 + hstep); PG8_STAGE_A(PG8_SA(0, 0), a2, 0, f2); \
            PG8_WAIT_V(8); PG8_WAIT_L(0); PG8_BAR; PG8_MMA(1, 0, At, B0, FX); PG8_MMA(1, 1, At, B1, FX); PG8_BAR; PG8_SCHED; \
            PG8_LDB(B0, 1, 0, FX); PG8_LDB(B1, 1, 1, FX); PG8_SCHED; PG8_LDA(At, 1, 0, FX); PG8_STAGE_A(PG8_SA(0, 1), a2, 1, f2); \
            PG8_WAIT_V(8); PG8_WAIT_L(0); PG8_BAR; PG8_MMA(0, 0, At, B0, FX); PG8_MMA(0, 1, At, B1, FX); PG8_BAR; PG8_SCHED; \
            PG8_LDA(At, 1, 1, FX); PG8_STAGE_B(PG8_SB(1, 0), b3); PG8_STAGE_B(PG8_SB(1, 1), b3 + hstep); PG8_STAGE_A(PG8_SA(1, 0), a3, 0, f2); \
            PG8_WAIT_V(8); PG8_WAIT_L(0); PG8_BAR; PG8_MMA(1, 0, At, B0, FX); PG8_MMA(1, 1, At, B1, FX); PG8_BAR; PG8_SCHED; } while (0)
#define PG8_TRIP_VARS() \
            const bool last = (t == nt - 2); \
            const unsigned a1 = PG8_AOFF(t + 1); \
            const unsigned a2 = last ? nA : PG8_AOFF(t + 2), b2 = last ? nB : cB + (unsigned)(t + 2) * kstep; \
            const unsigned a3 = a2 + kstep, b3 = b2 + kstep; \
            const bool f1 = MIXED && (t + 1 >= NTB), f2 = MIXED && !last && (t + 2 >= NTB); (void)f1; (void)f2;
        if constexpr (MIXED) {
#pragma unroll 1
            for (int t = 0; t < NTB; t += 2) { PG8_TRIP_VARS() PG8_TRIP(false); }
            { const int l2 = lane_volatile(); E.mid(acc, cur, wr, wc, l2 & 15, l2 >> 4); }
#pragma unroll 1
            for (int t = NTB; t < nt; t += 2) { PG8_TRIP_VARS() PG8_TRIP(true); }
        } else {
#pragma unroll 1
            for (int t = 0; t < nt; t += 2) {
                if constexpr (DUALA) { if (t == MIDT) { const int l2 = lane_volatile(); E.mid(acc, cur, wr, wc, l2 & 15, l2 >> 4); } }
                PG8_TRIP_VARS() PG8_TRIP(F8);
            }
        }
#undef PG8_TRIP_VARS
#undef PG8_TRIP
        if constexpr (ALIGN_EPI) { if (wr == 0) PG8_BAR; }
        { const int l2 = lane_volatile(); E(acc, cur, ui, wr, wc, l2 & 15, l2 >> 4); }
        if (!has_next) break;
#pragma unroll
        for (int a = 0; a < 2; ++a)
#pragma unroll
            for (int b = 0; b < 2; ++b)
#pragma unroll
                for (int m = 0; m < 4; ++m)
#pragma unroll
                    for (int n = 0; n < 2; ++n) { acc[a][b][m][n] = zero4_asm(); }
        cur = nxt; cA = nA; cA2 = nA2; cB = nB; ++ui;
        if constexpr (ALIGN_EPI) { if (wr == 1) PG8_BAR; }
    }
    PG8_WAIT_V(0);
    if constexpr (!ALIGN_EPI) { if (wr == 0) PG8_BAR; }
    PG8_BAR;
#undef PG8_SA
#undef PG8_SB
#undef PG8_DMA
#undef PG8_STAGE_B
#undef PG8_STAGE_A
#undef PG8_LDA
#undef PG8_LDB
#undef PG8_MMA
#undef PG8_F8OP
#undef PG8_WAIT_V
#undef PG8_WAIT_L
#undef PG8_BAR
#undef PG8_SCHED
#undef PG8_GLOAD
#undef PG8_AOFF
}
}

constexpr size_t MiB = 1u << 20;
constexpr size_t WS_CTL = 0, CTL_ZERO_BYTES = 1 * MiB;
constexpr size_t WS_CS = 1 * MiB;
constexpr size_t WS_WTS = 3 * MiB;
constexpr size_t WS_LIST = 672 * MiB;
constexpr size_t WS_WIN = 12 * MiB;
constexpr size_t WS_WC = 37 * MiB, WS_WA = 41 * MiB, WS_WO = 45 * MiB;
constexpr size_t WS_RW = 49 * MiB;
constexpr size_t WS_RSTD = 50 * MiB;
constexpr size_t WS_W13 = 64 * MiB;
constexpr size_t WS_W2 = 320 * MiB;
constexpr size_t WS_N = 448 * MiB;
constexpr size_t WS_U = 512 * MiB, WS_CC = 576 * MiB, WS_Q = 640 * MiB;
constexpr size_t WS_K = 704 * MiB, WS_VT = 712 * MiB;
constexpr size_t WS_G = 720 * MiB;
constexpr size_t WS_H = 848 * MiB;
constexpr size_t WS_H8 = WS_H + 64 * MiB;
constexpr size_t WS_O8 = WS_H8 + 32 * MiB;
constexpr size_t WS_WIN8 = 24 * MiB;
constexpr size_t WS_N8 = 976 * MiB;
constexpr size_t WS_END = 1008 * MiB;
constexpr int CW_BAR = 4096;
constexpr int CW_CNT = 65536;

constexpr int RING_OFF = 0, RING_BYTES = 131072;
constexpr int LDSCTL_OFF = RING_BYTES, MISC_OFF = LDSCTL_OFF + 320;
constexpr int WSLOT_OFF = LDSCTL_OFF + 512;
constexpr int TAB_OFF = RING_BYTES + 1024;
constexpr int TOK_OFF = TAB_OFF + 1024;
constexpr int WT_OFF = TOK_OFF + MAX_UNITS * 1024;
constexpr int TOKA_OFF = WT_OFF + MAX_UNITS * 1024;
constexpr int WTA_OFF = TOKA_OFF + MAX_UNITS * 1024;
constexpr int LDS_BYTES = 159744;
static_assert(WTA_OFF + MAX_UNITS * 1024 <= LDS_BYTES, "LDS map");

#define GAS __attribute__((address_space(1)))
#define LAS __attribute__((address_space(3)))
typedef unsigned short bf16;
typedef unsigned v4u __attribute__((ext_vector_type(4)));
typedef unsigned v2u __attribute__((ext_vector_type(2)));
typedef float f32x4 __attribute__((ext_vector_type(4)));
typedef float f32x16 __attribute__((ext_vector_type(16)));
typedef short bf16x8 __attribute__((ext_vector_type(8)));
typedef GAS unsigned gu32;
#define RLX_AGENT __ATOMIC_RELAXED, __HIP_MEMORY_SCOPE_AGENT
#define LDS_WAIT() asm volatile("s_waitcnt lgkmcnt(0)" ::: "memory")
#define VM_WAIT() asm volatile("s_waitcnt vmcnt(0)" ::: "memory")
__device__ __forceinline__ unsigned pk2(float lo, float hi) { return pg8::cvt_pk_bf16(lo, hi); }
__device__ __forceinline__ float bflo(unsigned w) { return __uint_as_float(w << 16); }
__device__ __forceinline__ float bfhi(unsigned w) { return __uint_as_float(w & 0xffff0000u); }

#define XB_TMO      128
#define XB_XCNT(j)  (256  + 64 * (j))
#define XB_XSUB(j)  (1280 + 64 * (j))
#define XB_XGEN(j)  (2304 + 64 * (j))
#define XB_TOP      3328
#define XB_TOPGEN   3392
#define XCD_BAR_WORDS 3456
#define XB_SPIN_CAP (1u << 22)
__device__ __forceinline__ unsigned* xb_at(unsigned* p) { unsigned long long z; asm volatile("v_mov_b64 %0, 0" : "=v"(z)); return (unsigned*)((char*)p + z); }
__device__ __forceinline__ unsigned xb_ld(unsigned* p)              { return __hip_atomic_load(xb_at(p), __ATOMIC_RELAXED, __HIP_MEMORY_SCOPE_AGENT); }
__device__ __forceinline__ unsigned xb_add(unsigned* p, unsigned v) { return __hip_atomic_fetch_add(xb_at(p), v, __ATOMIC_RELAXED, __HIP_MEMORY_SCOPE_AGENT); }
__device__ __forceinline__ unsigned xb_xcc_id() { return (unsigned)__builtin_amdgcn_s_getreg((3 << 11) | 20) & 0xFu; }
#define XB_SPIN(cond, bar) do { unsigned _sp = 0; while (cond) { __builtin_amdgcn_s_sleep(1); \
    if ((++_sp & 255u) == 0u) { if (xb_ld(&(bar)[XB_TMO])) break; if (_sp > XB_SPIN_CAP) { (void)xb_add(&(bar)[XB_TMO], 1u); break; } } } } while (0)
struct XcdBarrier { unsigned* bar; unsigned x; volatile LAS unsigned* st; };
__device__ __forceinline__ XcdBarrier xcd_barrier_post(unsigned* bar, volatile LAS unsigned* st, int tid) {
    XcdBarrier b; b.bar = bar; b.x = xb_xcc_id(); b.st = st;
    if (tid == 0) (void)xb_add(&bar[XB_XCNT(b.x)], 1u);
    return b;
}
__device__ __forceinline__ void xcd_barrier_complete(unsigned* bar, unsigned x, unsigned& nloc, unsigned& nx) {
    const unsigned G = gridDim.x * gridDim.y * gridDim.z;
    unsigned sum, cnt, mine, sp = 0u;
    for (;;) {
        sum = 0u; cnt = 0u; mine = 0u;
#pragma unroll
        for (unsigned j = 0; j < 16; ++j) { const unsigned c = xb_ld(&bar[XB_XCNT(j)]); sum += c; cnt += (c > 0u) ? 1u : 0u; mine = (j == x) ? c : mine; }
        if (sum == G) break;
        __builtin_amdgcn_s_sleep(1);
        if ((++sp & 255u) == 0u) { if (xb_ld(&bar[XB_TMO])) break; if (sp > XB_SPIN_CAP) { (void)xb_add(&bar[XB_TMO], 1u); break; } }
    }
    nloc = mine > 0u ? mine : 1u; nx = cnt > 0u ? cnt : 1u;
}
__device__ __forceinline__ void xcd_barrier(const XcdBarrier& b, int tid) {
    asm volatile("s_waitcnt vmcnt(0)" ::: "memory");
    __syncthreads();
    if (tid == 0) {
        unsigned* bar = b.bar;
        __builtin_amdgcn_s_waitcnt(0);
        unsigned nloc = b.st[0], nx = b.st[1];
        if (nloc == 0u) { xcd_barrier_complete(bar, b.x, nloc, nx); b.st[0] = nloc; b.st[1] = nx; }
        const unsigned old = xb_add(&bar[XB_XSUB(b.x)], 1u);
        const unsigned gen = old / nloc;
        if (old + 1u == (gen + 1u) * nloc) {
            __builtin_amdgcn_fence(__ATOMIC_RELEASE, "agent");
            asm volatile("s_waitcnt vmcnt(0)" ::: "memory");
            const unsigned og = xb_add(&bar[XB_TOP], 1u);
            const unsigned tg = og / nx;
            if (og + 1u == (tg + 1u) * nx) xb_add(&bar[XB_TOPGEN], 1u);
            else XB_SPIN(xb_ld(&bar[XB_TOPGEN]) == tg, bar);
            __builtin_amdgcn_fence(__ATOMIC_ACQUIRE, "agent");
            xb_add(&bar[XB_XGEN(b.x)], 1u);
            asm volatile("s_waitcnt vmcnt(0)" ::: "memory");
        } else {
            XB_SPIN(xb_ld(&bar[XB_XGEN(b.x)]) == gen, bar);
            __builtin_amdgcn_fence(__ATOMIC_ACQUIRE, "agent");
            asm volatile("s_waitcnt vmcnt(0)" ::: "memory");
        }
    }
    __syncthreads();
}

struct Args { const void* in[19]; float* out; unsigned char* ws; int ph_lo, ph_hi; };

__device__ __forceinline__ float xshfl(float v, int k, int lane) { return __int_as_float(__builtin_amdgcn_ds_bpermute((lane ^ k) << 2, __float_as_int(v))); }
__device__ __forceinline__ float wave_sum(float v, int lane) {
#pragma unroll
    for (int o = 1; o < 64; o <<= 1) v += xshfl(v, o, lane);
    return v;
}

struct CvtItem { const float* src; bf16* dst; unsigned char* dst8; const float* kscale; float oscale; int N, K, k0, perm; };
__device__ __forceinline__ void cvt_load(const CvtItem& d, f32x4 (&v)[16], int lane) {
    const int kk = lane >> 4, n4 = lane & 15;
#pragma unroll
    for (int i = 0; i < 16; ++i) v[i] = __builtin_nontemporal_load((const GAS f32x4*)(d.src + (size_t)(4 * i + kk) * d.N + 4 * n4));
}
__device__ __forceinline__ void cvt_finish(const CvtItem& d, f32x4 (&v)[16], LAS float* scr, int lane) {
    const int kk = lane >> 4, n4 = lane & 15;
    if (d.kscale) {
#pragma unroll
        for (int i = 0; i < 16; ++i) v[i] = v[i] * d.kscale[d.k0 + 4 * i + kk]; }
#pragma unroll
    for (int i = 0; i < 16; ++i) { const int k = 4 * i + kk; *(LAS f32x4*)(scr + k * 64 + 4 * (n4 ^ ((k >> 3) & 7))) = v[i]; }
    LDS_WAIT(); asm volatile("" ::: "memory");
    const int c = lane & 7, nlo = lane >> 3;
#pragma unroll
    for (int jj = 0; jj < 2; ++jj) { float x[4][8];
#pragma unroll
        for (int j = 0; j < 4; ++j) { const int pos = nlo + 8 * (4 * jj + j); int col = pos; if (d.perm && pos < 16) col = (pos >> 1) + 8 * (pos & 1);
            const LAS float* s = scr + (8 * c) * 64 + (col ^ (4 * c));
#pragma unroll
            for (int i = 0; i < 8; ++i) x[j][i] = s[i * 64]; }
#pragma unroll
        for (int j = 0; j < 4; ++j) { const int pos = nlo + 8 * (4 * jj + j);
            if (d.dst8) { const float sc = d.oscale;
                const v2u o8 = pg8::pack8_f8((f32x4){x[j][0] * sc, x[j][1] * sc, x[j][2] * sc, x[j][3] * sc}, (f32x4){x[j][4] * sc, x[j][5] * sc, x[j][6] * sc, x[j][7] * sc});
                __builtin_nontemporal_store(o8, (GAS v2u*)(d.dst8 + (size_t)pos * d.K + 8 * c)); }
            else {
            v4u o; o.x = pg8::cvt_pk_bf16_c(x[j][0], x[j][1]); o.y = pg8::cvt_pk_bf16_c(x[j][2], x[j][3]); o.z = pg8::cvt_pk_bf16_c(x[j][4], x[j][5]); o.w = pg8::cvt_pk_bf16_c(x[j][6], x[j][7]);
            __builtin_nontemporal_store(o, (GAS v4u*)(d.dst + (size_t)pos * d.K + 8 * c)); } } }
    LDS_WAIT(); asm volatile("" ::: "memory");
}
__device__ __forceinline__ int inproj_srccol(int np) {
    if (np < 2048) { const int t = np >> 8, r = np & 255; return (r < 128) ? (t * 128 + r) : (2048 + t * 128 + (r - 128)); }
    return 1024 + (np - 2048);
}
__device__ __forceinline__ int inproj8_srccol0(int n8) { return 3072 + n8; }

__device__ __forceinline__ void sincos_d(double ang, float& s, float& c) {
    const double k = __builtin_rint(ang * 0.6366197723675814);
    double r = __builtin_fma(-k, 1.5707963267948966, ang); r = __builtin_fma(-k, 6.123233995736766e-17, r);
    const double r2 = r * r;
    double sp = -1.0 / 1307674368000.0; sp = sp * r2 + 1.0 / 6227020800.0; sp = sp * r2 - 1.0 / 39916800.0; sp = sp * r2 + 1.0 / 362880.0; sp = sp * r2 - 1.0 / 5040.0; sp = sp * r2 + 1.0 / 120.0; sp = sp * r2 - 1.0 / 6.0; sp = sp * r2 * r + r;
    double cp = 1.0 / 20922789888000.0; cp = cp * r2 - 1.0 / 87178291200.0; cp = cp * r2 + 1.0 / 479001600.0; cp = cp * r2 - 1.0 / 3628800.0; cp = cp * r2 + 1.0 / 40320.0; cp = cp * r2 - 1.0 / 720.0; cp = cp * r2 + 1.0 / 24.0; cp = cp * r2 - 0.5; cp = cp * r2 + 1.0;
    const int q = (int)((long long)k & 3);
    const double ss = (q == 0) ? sp : (q == 1) ? cp : (q == 2) ? -sp : -cp;
    const double cc = (q == 0) ? cp : (q == 1) ? -sp : (q == 2) ? -cp : sp;
    s = (float)ss; c = (float)cc;
}

struct RowIn { f32x4 v[4]; v2u h[4]; unsigned a[4], b[4]; };
template <int MODE> __device__ __forceinline__ void norm_load(RowIn& r, int lane, const float* xin, const bf16* hin, const unsigned char* s0, const unsigned char* s1) {
    if (MODE == 0) { const GAS f32x4* xr = (const GAS f32x4*)xin + lane;
#pragma unroll
        for (int j = 0; j < 4; ++j) r.v[j] = xr[64 * j]; }
    else { const GAS v2u* hr = (const GAS v2u*)hin + lane; const GAS unsigned* a = (const GAS unsigned*)s0 + lane; const GAS unsigned* b = (const GAS unsigned*)s1 + lane;
#pragma unroll
        for (int j = 0; j < 4; ++j) { r.h[j] = hr[64 * j]; r.a[j] = a[64 * j]; r.b[j] = b[64 * j]; } }
}
template <int MODE> __device__ __forceinline__ void norm_finish(RowIn& r, int lane, bf16* hsum, const f32x4 (&gg)[4], bf16* nout, unsigned char* n8out, float* fout) {
    f32x4 v[4]; float ss = 0.f;
    if (MODE == 0) {
#pragma unroll
        for (int j = 0; j < 4; ++j) v[j] = r.v[j]; }
    else {
#pragma unroll
        for (int j = 0; j < 4; ++j) { const v2u h = r.h[j]; typedef float f2 __attribute__((ext_vector_type(2)));
            const f2 x0 = __builtin_amdgcn_cvt_pk_f32_fp8((int)r.a[j], false), x1 = __builtin_amdgcn_cvt_pk_f32_fp8((int)r.a[j], true);
            const f2 y0 = __builtin_amdgcn_cvt_pk_f32_fp8((int)r.b[j], false), y1 = __builtin_amdgcn_cvt_pk_f32_fp8((int)r.b[j], true);
            v[j] = (f32x4){bflo(h.x), bfhi(h.x), bflo(h.y), bfhi(h.y)} + ((f32x4){x0.x, x0.y, x1.x, x1.y} + (f32x4){y0.x, y0.y, y1.x, y1.y}) * (1.0f / pg8::SLAB_SCALE); } }
    if (MODE == 1) { GAS v2u* o = (GAS v2u*)hsum + lane;
#pragma unroll
        for (int j = 0; j < 4; ++j) { v2u w; w.x = pk2(v[j].x, v[j].y); w.y = pk2(v[j].z, v[j].w); o[64 * j] = w; v[j] = (f32x4){bflo(w.x), bfhi(w.x), bflo(w.y), bfhi(w.y)}; } }
#pragma unroll
    for (int j = 0; j < 4; ++j) ss += (v[j].x * v[j].x + v[j].y * v[j].y) + (v[j].z * v[j].z + v[j].w * v[j].w);
    const float rstd = 1.f / sqrtf(wave_sum(ss, lane) * (1.f / D) + RMS_EPS);
#pragma unroll
    for (int j = 0; j < 4; ++j) v[j] = v[j] * rstd * gg[j];
    if (MODE != 2) { GAS v2u* o = (GAS v2u*)nout + lane; GAS int* o8 = (GAS int*)n8out + lane;
#pragma unroll
        for (int j = 0; j < 4; ++j) { v2u w; w.x = pk2(v[j].x, v[j].y); w.y = pk2(v[j].z, v[j].w); o[64 * j] = w;
            int w8 = __builtin_bit_cast(int, v[j].x); w8 = __builtin_amdgcn_cvt_pk_fp8_f32(v[j].x, v[j].y, w8, false); w8 = __builtin_amdgcn_cvt_pk_fp8_f32(v[j].z, v[j].w, w8, true); o8[64 * j] = w8; } }
    else { GAS f32x4* o = (GAS f32x4*)fout + lane;
#pragma unroll
        for (int j = 0; j < 4; ++j) o[64 * j] = v[j]; }
}
#define NORM_LOAD2(ra_, rb_, m_) do { const int ma_ = (m_), mb_ = ma_ + NGW; \
        norm_load<MODE>(ra_, lane, MODE == 0 ? xin + (size_t)ma_ * D : nullptr, MODE ? h16 + (size_t)ma_ * D : nullptr, MODE ? slab + (size_t)(2 * ma_) * D : nullptr, MODE ? slab + (size_t)(2 * ma_ + 1) * D : nullptr); \
        if (mb_ < T) norm_load<MODE>(rb_, lane, MODE == 0 ? xin + (size_t)mb_ * D : nullptr, MODE ? h16 + (size_t)mb_ * D : nullptr, MODE ? slab + (size_t)(2 * mb_) * D : nullptr, MODE ? slab + (size_t)(2 * mb_ + 1) * D : nullptr); } while (0)
#define NORM_FIN2(ra_, rb_, m_) do { const int ma_ = (m_), mb_ = ma_ + NGW; \
        norm_finish<MODE>(ra_, lane, MODE == 1 ? h16 + (size_t)ma_ * D : nullptr, gg, MODE != 2 ? nout + (size_t)ma_ * D : nullptr, MODE != 2 ? n8out + (size_t)ma_ * D : nullptr, MODE == 2 ? fout + (size_t)ma_ * D : nullptr); \
        if (mb_ < T) norm_finish<MODE>(rb_, lane, MODE == 1 ? h16 + (size_t)mb_ * D : nullptr, gg, MODE != 2 ? nout + (size_t)mb_ * D : nullptr, MODE != 2 ? n8out + (size_t)mb_ * D : nullptr, MODE == 2 ? fout + (size_t)mb_ * D : nullptr); } while (0)
template <int MODE> __device__ __forceinline__ void norm_rows(int lane, int gw, int NGW, const float* xin, bf16* h16, const unsigned char* slab, const float* g, bf16* nout, unsigned char* n8out, float* fout) {
    int m = gw; if (m >= T) return;
    f32x4 gg[4];
    { const GAS f32x4* gr = (const GAS f32x4*)g + lane;
#pragma unroll
      for (int j = 0; j < 4; ++j) gg[j] = gr[64 * j]; }
    RowIn a0, a1, b0, b1;
    NORM_LOAD2(a0, a1, m);
    for (;;) {
        const int mn = m + 2 * NGW; const bool hasn = mn < T;
        if (hasn) NORM_LOAD2(b0, b1, mn);
        NORM_FIN2(a0, a1, m);
        if (!hasn) break;
        m = mn + 2 * NGW; const bool has2 = m < T;
        if (has2) NORM_LOAD2(a0, a1, m);
        NORM_FIN2(b0, b1, mn);
        if (!has2) break;
    }
}
#undef NORM_LOAD2
#undef NORM_FIN2

constexpr int RT_BROW = 528, RT_BHALF = 80 * RT_BROW, RT_LG_OFF = 86016, RT_LGROW = 81;
__device__ __forceinline__ void router_block(LAS unsigned char* lds, int tid, int r0, const bf16* H, const bf16* WR, const float* bg, const float* broute,
                                             unsigned* cnt, int* lists, float* wts, float* rstd_out) {
    const int lane = tid & 63, wave = __builtin_amdgcn_readfirstlane(tid >> 6), fr = lane & 15, fq = lane >> 4;
    const bf16* hrow = H + (size_t)(r0 + wave * 16 + fr) * D + 8 * fq;
    LAS unsigned* cntB = (LAS unsigned*)(lds + TAB_OFF); LAS unsigned* baseB = cntB + 64;
    if (tid < 64) cntB[tid] = 0u;
    f32x4 acc[5];
#pragma unroll
    for (int nb = 0; nb < 5; ++nb) acc[nb] = (f32x4){0.f, 0.f, 0.f, 0.f};
    float ssq = 0.f;
    v4u av[8]; v4u bw[10];
#define RT_LOADB(c_) do { _Pragma("unroll") for (int i = 0; i < 10; ++i) { const int q = tid + 512 * i; const int hl = q / 2560, rem = q % 2560, n = rem >> 5, ch = rem & 31; \
            bw[i] = *(const GAS v4u*)(WR + ((size_t)hl * 80 + n) * D + (c_) * 256 + ch * 8); } } while (0)
#pragma unroll
    for (int ks = 0; ks < 8; ++ks) av[ks] = *(const GAS v4u*)(hrow + ks * 32);
    RT_LOADB(0);
#pragma unroll
    for (int c = 0; c < 4; ++c) {
        __syncthreads();
#pragma unroll
        for (int i = 0; i < 10; ++i) { const int q = tid + 512 * i; const int hl = q / 2560, rem = q % 2560, n = rem >> 5, ch = rem & 31;
            *(LAS v4u*)(lds + hl * RT_BHALF + n * RT_BROW + ch * 16) = bw[i]; }
        __syncthreads();
        if (c < 3) RT_LOADB(c + 1);
#pragma unroll
        for (int ks = 0; ks < 8; ++ks) {
            const v4u a = av[ks];
            if (c < 3) av[ks] = *(const GAS v4u*)(hrow + (c + 1) * 256 + ks * 32);
            { const float x0 = bflo(a.x), x1 = bfhi(a.x), x2 = bflo(a.y), x3 = bfhi(a.y), x4 = bflo(a.z), x5 = bfhi(a.z), x6 = bflo(a.w), x7 = bfhi(a.w);
              ssq += (x0 * x0 + x1 * x1) + (x2 * x2 + x3 * x3) + (x4 * x4 + x5 * x5) + (x6 * x6 + x7 * x7); }
            const bf16x8 ah = __builtin_bit_cast(bf16x8, a);
#pragma unroll
            for (int nb = 0; nb < 5; ++nb) {
                const bf16x8 bh = *(const LAS bf16x8*)(lds + (nb * 16 + fr) * RT_BROW + ks * 64 + fq * 16);
                const bf16x8 bl = *(const LAS bf16x8*)(lds + RT_BHALF + (nb * 16 + fr) * RT_BROW + ks * 64 + fq * 16);
                acc[nb] = __builtin_amdgcn_mfma_f32_16x16x32_bf16(ah, bh, acc[nb], 0, 0, 0);
                acc[nb] = __builtin_amdgcn_mfma_f32_16x16x32_bf16(ah, bl, acc[nb], 0, 0, 0);
            }
        }
    }
#undef RT_LOADB
    ssq += xshfl(ssq, 16, lane); ssq += xshfl(ssq, 32, lane);
    const float rs = 1.f / sqrtf(ssq * (1.f / D) + RMS_EPS);
    LAS float* LG = (LAS float*)(lds + RT_LG_OFF) + wave * 16 * RT_LGROW;
#pragma unroll
    for (int nb = 0; nb < 5; ++nb)
#pragma unroll
        for (int i = 0; i < 4; ++i) LG[(4 * fq + i) * RT_LGROW + nb * 16 + fr] = acc[nb][i];
    LDS_WAIT(); asm volatile("" ::: "memory");
    int ea = 0, eb = 0; unsigned ra = 0u, rb = 0u; float wa = 0.f, wb = 0.f;
    if (lane < 16) {
        const LAS float* lr = LG + lane * RT_LGROW;
        unsigned long long z_; asm volatile("v_mov_b64 %0, 0" : "=v"(z_)); const float* bgz = (const float*)((const char*)bg + z_);
        float lg[8];
#pragma unroll
        for (int e = 0; e < 8; ++e) lg[e] = lr[e] * rs + bgz[e];
        int gi = 0; float gm = lg[0];
#pragma unroll
        for (int e = 1; e < 8; ++e) if (lg[e] > gm) { gm = lg[e]; gi = e; }
        float gs = 0.f;
#pragma unroll
        for (int e = 0; e < 8; ++e) gs += __expf(lg[e] - gm);
        const float pgroup = 1.f / gs;
        float le[8];
#pragma unroll
        for (int e = 0; e < 8; ++e) le[e] = lr[8 + gi * 8 + e] * rs + broute[gi * 8 + e];
        int i1 = 0; float m1 = le[0];
#pragma unroll
        for (int e = 1; e < 8; ++e) if (le[e] > m1) { m1 = le[e]; i1 = e; }
        int i2 = -1; float m2 = -INFINITY;
#pragma unroll
        for (int e = 0; e < 8; ++e) if (e != i1 && le[e] > m2) { m2 = le[e]; i2 = e; }
        const float e2 = __expf(m2 - m1); const float inv = 1.f / (1.f + e2);
        ea = gi * 8 + i1; eb = gi * 8 + i2; wa = pgroup * inv; wb = pgroup * e2 * inv;
        ra = __hip_atomic_fetch_add(cntB + ea, 1u, __ATOMIC_RELAXED, __HIP_MEMORY_SCOPE_WORKGROUP); rb = __hip_atomic_fetch_add(cntB + eb, 1u, __ATOMIC_RELAXED, __HIP_MEMORY_SCOPE_WORKGROUP);
    }
    __syncthreads();
    if (tid < 64) { const unsigned n = cntB[tid]; unsigned b0 = 0u; if (n) b0 = atomicAdd(cnt + tid * 16, n); baseB[tid] = b0; }
    __syncthreads();
    if (lane < 16) {
        const int t = r0 + wave * 16 + lane;
        const unsigned sa = baseB[ea] + ra, sb = baseB[eb] + rb;
        const unsigned rsb = __float_as_uint(rs);
        ((GAS v4u*)lists)[(size_t)ea * LIST_CAP + sa] = (v4u){(unsigned)(2 * t), __float_as_uint(wa), rsb, 0u};
        ((GAS v4u*)lists)[(size_t)eb * LIST_CAP + sb] = (v4u){(unsigned)(2 * t + 1), __float_as_uint(wb), rsb, 0u};
        (void)wts; (void)rstd_out;
    }
}

constexpr int KROW = 144, VROW = 400, KIMG = 192 * KROW, VIMG = 64 * VROW;
#define ATT_LOADKV(u_) do { const int kh_ = (u_) & 1, c_ = ((u_) >> 1) & 127, b_ = (u_) >> 8; \
        _Pragma("unroll") for (int i = 0; i < 3; ++i) { const int q = tid + 512 * i; const int row = q >> 3, ch = q & 7; int cj = c_ - 2 + (row >> 6); cj = cj < 0 ? 0 : cj; \
            kreg[i] = *(const GAS v4u*)(Kb + ((size_t)(b_ * SEQ + cj * 64 + (row & 63))) * 128 + kh_ * 64 + ch * 8); } \
        _Pragma("unroll") for (int i = 0; i < 3; ++i) { const int q = tid + 512 * i; const int d = q / 24, rem = q % 24, j = rem >> 3, ch = rem & 7; int cj = c_ - 2 + j; cj = cj < 0 ? 0 : cj; \
            vreg[i] = *(const GAS v4u*)(VT + ((size_t)((b_ * 2 + kh_) * 64 + d)) * SEQ + cj * 64 + ch * 8); } } while (0)
__device__ __forceinline__ void attn_phase(LAS unsigned char* lds, int tid, int vcu, int G, const unsigned char* Q, unsigned char* O, const bf16* Kb, const bf16* VT, const float* sinks) {
    const int lane = tid & 63, wid = __builtin_amdgcn_readfirstlane(tid >> 6), r32 = lane & 31, hi = lane >> 5;
    constexpr int NUNITS = BATCH * (SEQ / CHUNK) * NKV;
    const int sig = (r32 & 19) | ((r32 & 4) << 1) | ((r32 & 8) >> 1);
    const LAS unsigned char* kbase = lds + sig * KROW + hi * 16;
    const LAS unsigned char* vbase = lds + KIMG + r32 * VROW + hi * 16;
    v4u kreg[3], vreg[3];
    const float sink0 = sinks[wid] * LOG2E, sink1 = sinks[8 + wid] * LOG2E;
#define ATT_UNIT(k_) ((G == 256) ? ((k_) < 4 ? (((vcu >> 5) >> 1) << 8) | ((64 * ((vcu >> 5) & 1) + (((vcu & 31) + 32 * (k_)) >> 1)) << 1) | (((vcu & 31) + 32 * (k_)) & 1) : NUNITS) : vcu + (k_) * G)
    if (ATT_UNIT(0) < NUNITS) ATT_LOADKV(ATT_UNIT(0));
    for (int ku = 0; ; ++ku) {
        const int u = ATT_UNIT(ku); if (u >= NUNITS) break;
        const int kh = u & 1, c = (u >> 1) & 127, b = u >> 8;
        __syncthreads();
#pragma unroll
        for (int i = 0; i < 3; ++i) { const int q = tid + 512 * i; const int row = q >> 3, ch = q & 7; *(LAS v4u*)(lds + row * KROW + ch * 16) = kreg[i]; }
#pragma unroll
        for (int i = 0; i < 3; ++i) { const int q = tid + 512 * i; const int d = q / 24, rem = q % 24, j = rem >> 3, ch = rem & 7; *(LAS v4u*)(lds + KIMG + d * VROW + j * 128 + ch * 16) = vreg[i]; }
        __syncthreads();
        const int head = kh * 8 + wid;
        const size_t tok0 = (size_t)b * SEQ + c * 64 + r32;
        bf16x8 qr[2][4];
        v2u qraw[2][4];
#pragma unroll
        for (int qt = 0; qt < 2; ++qt)
#pragma unroll
            for (int d0 = 0; d0 < 4; ++d0) qraw[qt][d0] = *(const GAS v2u*)(Q + (tok0 + qt * 32) * D + head * 64 + d0 * 16 + hi * 8);
#pragma unroll
        for (int qt = 0; qt < 2; ++qt)
#pragma unroll
            for (int d0 = 0; d0 < 4; ++d0) { const v2u q8 = qraw[qt][d0];
                typedef float f2 __attribute__((ext_vector_type(2))); constexpr float QI = 1.0f / pg8::Q8_SCALE;
                const f2 a0 = __builtin_amdgcn_cvt_pk_f32_fp8((int)q8.x, false), a1 = __builtin_amdgcn_cvt_pk_f32_fp8((int)q8.x, true), b0 = __builtin_amdgcn_cvt_pk_f32_fp8((int)q8.y, false), b1 = __builtin_amdgcn_cvt_pk_f32_fp8((int)q8.y, true);
                v4u w; w.x = pk2(a0.x * QI, a0.y * QI); w.y = pk2(a1.x * QI, a1.y * QI); w.z = pk2(b0.x * QI, b0.y * QI); w.w = pk2(b1.x * QI, b1.y * QI);
                qr[qt][d0] = __builtin_bit_cast(bf16x8, w); }
        { const int un = ATT_UNIT(ku + 1); if (un < NUNITS) ATT_LOADKV(un); }
        const float sinkl2 = kh ? sink1 : sink0;
#pragma unroll
        for (int qt = 0; qt < 2; ++qt) {
            unsigned char* op = O + (tok0 + qt * 32) * D + head * 64;
            f32x16 s[6];
#pragma unroll
            for (int t = 0; t < 6; ++t) {
                s[t] = (f32x16){0.f, 0.f, 0.f, 0.f, 0.f, 0.f, 0.f, 0.f, 0.f, 0.f, 0.f, 0.f, 0.f, 0.f, 0.f, 0.f};
#pragma unroll
                for (int d0 = 0; d0 < 4; ++d0) { const bf16x8 kf = *(const LAS bf16x8*)(kbase + t * 32 * KROW + d0 * 32);
                    s[t] = __builtin_amdgcn_mfma_f32_32x32x16_bf16(kf, qr[qt][d0], s[t], 0, 0, 0); }
            }
            if (c < 2) {
                asm volatile("" ::: "memory");
#pragma unroll
                for (int t = 0; t < 6; ++t) if (c - 2 + (t >> 1) < 0) {
#pragma unroll
                    for (int r = 0; r < 16; ++r) s[t][r] = -INFINITY; } }
            float m = sinkl2;
#pragma unroll
            for (int t = 0; t < 6; ++t)
#pragma unroll
                for (int r = 0; r < 16; ++r) m = fmaxf(m, s[t][r]);
            m = fmaxf(m, xshfl(m, 32, lane));
            float l = 0.f;
#pragma unroll
            for (int t = 0; t < 6; ++t)
#pragma unroll
                for (int r = 0; r < 16; ++r) { s[t][r] = __builtin_amdgcn_exp2f(s[t][r] - m); l += s[t][r]; }
            l += xshfl(l, 32, lane);
            l += __builtin_amdgcn_exp2f(sinkl2 - m);
            const float rl = 1.f / l;
            f32x16 o[2];
#pragma unroll
            for (int dt = 0; dt < 2; ++dt) o[dt] = (f32x16){0.f, 0.f, 0.f, 0.f, 0.f, 0.f, 0.f, 0.f, 0.f, 0.f, 0.f, 0.f, 0.f, 0.f, 0.f, 0.f};
#pragma unroll
            for (int t = 0; t < 6; ++t)
#pragma unroll
                for (int ks = 0; ks < 2; ++ks) {
                    v4u pw; pw.x = pk2(s[t][8 * ks + 0], s[t][8 * ks + 1]); pw.y = pk2(s[t][8 * ks + 2], s[t][8 * ks + 3]); pw.z = pk2(s[t][8 * ks + 4], s[t][8 * ks + 5]); pw.w = pk2(s[t][8 * ks + 6], s[t][8 * ks + 7]);
                    const bf16x8 pf = __builtin_bit_cast(bf16x8, pw);
#pragma unroll
                    for (int dt = 0; dt < 2; ++dt) { const bf16x8 vf = *(const LAS bf16x8*)(vbase + dt * 32 * VROW + (t * 32 + ks * 16) * 2);
                        o[dt] = __builtin_amdgcn_mfma_f32_32x32x16_bf16(vf, pf, o[dt], 0, 0, 0); }
                }
            {
                typedef unsigned u2_t __attribute__((ext_vector_type(2)));
                unsigned wq[2][4];
#pragma unroll
                for (int dt = 0; dt < 2; ++dt)
#pragma unroll
                    for (int g = 0; g < 4; ++g) { const float o0_ = o[dt][4 * g] * rl; int w = __builtin_bit_cast(int, o0_);
                        w = __builtin_amdgcn_cvt_pk_fp8_f32(o0_, o[dt][4 * g + 1] * rl, w, false); w = __builtin_amdgcn_cvt_pk_fp8_f32(o[dt][4 * g + 2] * rl, o[dt][4 * g + 3] * rl, w, true);
                        wq[dt][g] = (unsigned)w; }
                v4u lo4, hi4;
                { const u2_t r0 = __builtin_amdgcn_permlane32_swap(wq[0][0], wq[1][0], false, false), r1 = __builtin_amdgcn_permlane32_swap(wq[0][1], wq[1][1], false, false);
                  const u2_t r2 = __builtin_amdgcn_permlane32_swap(wq[0][2], wq[1][2], false, false), r3 = __builtin_amdgcn_permlane32_swap(wq[0][3], wq[1][3], false, false);
                  lo4 = (v4u){r0.x, r0.y, r1.x, r1.y}; hi4 = (v4u){r2.x, r2.y, r3.x, r3.y}; }
                *(GAS v4u*)(op + hi * 32) = lo4; *(GAS v4u*)(op + hi * 32 + 16) = hi4; }
        }
    }
    __syncthreads();
}
#undef ATT_LOADKV
#undef ATT_UNIT

__device__ __forceinline__ void conv_item(int tid, int item, const bf16* U, const bf16* CCb, const float* cw, bf16* AO) {
    const int cg = tid & 127, rq = tid >> 7; const int t0 = item * 64 + rq * 16; const int s0 = t0 & (SEQ - 1); const int ch = cg * 8;
#define CV_UNPACK8(dst_, x_) do { dst_[0] = bflo((x_).x); dst_[1] = bfhi((x_).x); dst_[2] = bflo((x_).y); dst_[3] = bfhi((x_).y); dst_[4] = bflo((x_).z); dst_[5] = bfhi((x_).z); dst_[6] = bflo((x_).w); dst_[7] = bfhi((x_).w); } while (0)
    const auto rU = __builtin_amdgcn_make_buffer_rsrc((void*)U, 0, 0xffffffff, 0x00020000);
    const auto rC = __builtin_amdgcn_make_buffer_rsrc((void*)CCb, 0, 0xffffffff, 0x00020000);
    const int oc = 2 * (t0 * D + ch);
    v4u xu[16], x2 = {0u, 0u, 0u, 0u}, x1 = {0u, 0u, 0u, 0u}; v4u xc[16];
    if (s0 >= 2) x2 = __builtin_bit_cast(v4u, __builtin_amdgcn_raw_buffer_load_b128(rU, oc - 4 * D, 0, 0));
    if (s0 >= 1) x1 = __builtin_bit_cast(v4u, __builtin_amdgcn_raw_buffer_load_b128(rU, oc - 2 * D, 0, 0));
#pragma unroll
    for (int r = 0; r < 16; ++r) { xu[r] = __builtin_bit_cast(v4u, __builtin_amdgcn_raw_buffer_load_b128(rU, oc, r * D * 2, 0)); xc[r] = __builtin_bit_cast(v4u, __builtin_amdgcn_raw_buffer_load_b128(rC, oc, r * D * 2, 0)); }
    float w[3][8];
#pragma unroll
    for (int j = 0; j < 3; ++j) { const f32x4 a = *(const GAS f32x4*)(cw + j * D + ch), b = *(const GAS f32x4*)(cw + j * D + ch + 4);
        w[j][0] = a.x; w[j][1] = a.y; w[j][2] = a.z; w[j][3] = a.w; w[j][4] = b.x; w[j][5] = b.y; w[j][6] = b.z; w[j][7] = b.w; }
    float p2[8], p1[8];
    CV_UNPACK8(p2, x2); CV_UNPACK8(p1, x1);
#pragma unroll
    for (int r = 0; r < 16; ++r) {
        float u0[8]; CV_UNPACK8(u0, xu[r]);
        float c0[8]; CV_UNPACK8(c0, xc[r]);
        float y[8];
#pragma unroll
        for (int k = 0; k < 8; ++k) { y[k] = c0[k] * (w[0][k] * p2[k] + w[1][k] * p1[k] + w[2][k] * u0[k]); p2[k] = p1[k]; p1[k] = u0[k]; }
        v4u ov; ov.x = pk2(y[0], y[1]); ov.y = pk2(y[2], y[3]); ov.z = pk2(y[4], y[5]); ov.w = pk2(y[6], y[7]);
        *(GAS v4u*)(AO + (size_t)(t0 + r) * D + ch) = ov;
    }
#undef CV_UNPACK8
}

constexpr int NWAVES = 8;
constexpr int PH_PER_LAYER = 9;
constexpr int N_PHASES = 1 + DEPTH * PH_PER_LAYER + 1;

__device__ __forceinline__ int my_lane_volatile() { int l; asm volatile("v_mbcnt_lo_u32_b32 %0, -1, 0\n\tv_mbcnt_hi_u32_b32 %0, -1, %0" : "=v"(l)); return l; }
typedef __attribute__((address_space(4))) const Args* KArgs;
constexpr int CI_IN = 16 * 100, CI_SQ = 16 * 16, CI_13 = 16 * 16 * 64, CI_2 = 8 * 16 * 64, CI_SMALL = CI_IN + 3 * CI_SQ, CI_EXP = CI_13 + CI_2;
__device__ __forceinline__ CvtItem cvt_decode(KArgs A, unsigned char* ws, int kind, int it) {
    CvtItem d; d.kscale = nullptr; d.perm = 0; d.dst8 = nullptr; d.dst = nullptr; d.oscale = 1.f;
    const int per_layer = kind == 0 ? CI_SMALL : CI_EXP; const int l = it / per_layer; int r = it % per_layer;
    if (kind == 0) {
        if (r < CI_IN) { const int kb = r / 100, grp = r % 100; d.N = IN_COLS; d.K = D; d.k0 = kb * 64;
            if (grp < 48) { const int n0 = grp * 64;
                d.src = (const float*)A->in[3] + (size_t)l * D * IN_COLS + (size_t)d.k0 * IN_COLS + inproj_srccol(n0); d.dst = (bf16*)(ws + WS_WIN) + (size_t)l * 3072 * D + (size_t)n0 * D + d.k0; }
            else { const int n8 = (grp - 48) * 64; d.perm = (n8 < 1152) ? 1 : 0; d.oscale = pg8::WIN8_SCALE;
                d.src = (const float*)A->in[3] + (size_t)l * D * IN_COLS + (size_t)d.k0 * IN_COLS + inproj8_srccol0(n8); d.dst8 = (unsigned char*)(ws + WS_WIN8) + (size_t)l * 3328 * D + (size_t)n8 * D + d.k0; } }
        else { r -= CI_IN; const int w = r / CI_SQ; const int rr = r % CI_SQ; const int kb = rr / 16, n0 = (rr % 16) * 64; d.N = D; d.k0 = kb * 64;
            d.src = (const float*)A->in[7 + w] + (size_t)l * D * D + (size_t)d.k0 * D + n0;
            if (w == 0) { d.K = 1536; d.dst = (bf16*)(ws + WS_WC + (size_t)l * D * 3072) + (size_t)n0 * 1536 + d.k0; }
            else if (w == 1) { d.K = 3072; d.oscale = pg8::WA_SCALE; d.dst8 = (unsigned char*)(ws + WS_WC + (size_t)l * D * 3072) + (size_t)n0 * 3072 + 2048 + d.k0; }
            else { d.K = D; d.dst = (bf16*)(ws + WS_WO) + (size_t)l * D * D + (size_t)n0 * D + d.k0; } }
    } else {
        if (r < CI_13) { const int e = r / 256, rr = r % 256; const int kb = rr / 16, n0 = (rr % 16) * 64; const int which = (n0 >> 7) & 1; const int sc0 = (n0 >> 8) * 128 + (n0 & 127);
            d.N = FF; d.K = D; d.k0 = kb * 64; d.kscale = (const float*)A->in[10] + l * D;
            d.src = (const float*)A->in[15 + which] + ((size_t)(l * NEXP + e)) * D * FF + (size_t)d.k0 * FF + sc0; d.oscale = pg8::W13_SCALE;
            d.dst8 = (unsigned char*)(ws + WS_W13) + ((size_t)(l * NEXP + e)) * 1024 * D + (size_t)n0 * D + d.k0; }
        else { r -= CI_13; const int e = r / 128, rr = r % 128; const int kb = rr / 16, n0 = (rr % 16) * 64; d.N = D; d.K = FF; d.k0 = kb * 64;
            d.src = (const float*)A->in[17] + ((size_t)(l * NEXP + e)) * FF * D + (size_t)d.k0 * D + n0; d.oscale = pg8::W2_SCALE;
            d.dst8 = (unsigned char*)(ws + WS_W2) + ((size_t)(l * NEXP + e)) * D * FF + (size_t)n0 * FF + d.k0; }
    }
    return d;
}
__device__ __forceinline__ void convert_items(KArgs A, unsigned char* ws, LAS unsigned char* lds, int kind, int lane, int wave, int gw, int NGW, int end) {
    LAS float* scr = (LAS float*)(lds + RING_OFF + wave * 16384);
    int it0 = gw; if (it0 >= end) return;
    f32x4 va[16], vb[16];
    CvtItem d0 = cvt_decode(A, ws, kind, it0), d1 = d0; cvt_load(d0, va, lane);
    for (;;) {
        const int it1 = it0 + NGW; const bool has1 = it1 < end;
        if (has1) { d1 = cvt_decode(A, ws, kind, it1); cvt_load(d1, vb, lane); }
        cvt_finish(d0, va, scr, lane);
        if (!has1) break;
        it0 = it1 + NGW; const bool has0 = it0 < end;
        if (has0) { d0 = cvt_decode(A, ws, kind, it0); cvt_load(d0, va, lane); }
        cvt_finish(d1, vb, scr, lane);
        if (!has0) break;
    }
}
__device__ __forceinline__ KArgs kargs() { KArgs p = (KArgs)__builtin_amdgcn_kernarg_segment_ptr(); asm volatile("" : "+s"(p)); return p; }

template <int L> struct LayerTag { static constexpr int value = L; };
__global__ void __launch_bounds__(NWAVES * 64, 2) fwd_kernel(Args args_unused) {
    extern __shared__ __attribute__((aligned(16))) unsigned char lds_raw[];
    LAS unsigned char* lds = (LAS unsigned char*)lds_raw;
#define HW_SLOT() ((int)__builtin_amdgcn_s_getreg((5 << 11) | 4) & 63)
#define MY_TID() (((volatile LAS int*)(lds + WSLOT_OFF))[HW_SLOT()] * 64 + my_lane_volatile())
    {   const int tid0 = threadIdx.x;
        { unsigned z0_; asm volatile("v_mov_b32 %0, 0" : "=v"(z0_));
          for (int u = tid0; u < (TAB_OFF - LDSCTL_OFF) / 4; u += NWAVES * 64) ((LAS unsigned*)(lds + LDSCTL_OFF))[u] = z0_; }
        __syncthreads();
        if ((tid0 & 63) == 0) ((volatile LAS int*)(lds + WSLOT_OFF))[HW_SLOT()] = tid0 >> 6;
        __syncthreads();
        if (!MK_PER_PHASE) { KArgs A = kargs(); (void)xcd_barrier_post((unsigned*)((gu32*)(A->ws + WS_CTL) + CW_BAR), (volatile LAS unsigned*)(lds + MISC_OFF) + 8, tid0); }
    }
#define PH_LOCALS \
    KArgs A = kargs(); unsigned char* ws = A->ws; (void)ws; \
    int tid_ = MY_TID(); asm volatile("" : "+v"(tid_)); const int tid = tid_, lane = tid & 63, wave = __builtin_amdgcn_readfirstlane(tid >> 6); (void)lane; (void)wave; \
    const int G = gridDim.x; const int bx = blockIdx.x; const int vcu = (G % 8 == 0) ? (bx % 8) * (G / 8) + bx / 8 : bx; (void)vcu; \
    const int gw = vcu * NWAVES + wave, NGW = G * NWAVES; (void)gw; (void)NGW;
#define IN(k) (kargs()->ph_lo <= (k) && (k) < kargs()->ph_hi)
#define SEAM(k) do { if (!MK_PER_PHASE && IN(k) && IN((k) + 1)) { KArgs A_ = kargs(); XcdBarrier bar_; bar_.bar = (unsigned*)((gu32*)(A_->ws + WS_CTL) + CW_BAR); bar_.x = xb_xcc_id(); \
        bar_.st = (volatile LAS unsigned*)(lds + MISC_OFF) + 8; xcd_barrier(bar_, MY_TID()); } } while (0)

    if (IN(0)) {
        PH_LOCALS
        convert_items(A, ws, lds, 0, lane, wave, gw, NGW, DEPTH * CI_SMALL);
        { const int* positions = (const int*)A->in[1]; float* CS = (float*)(ws + WS_CS);
          for (int idx = vcu * 512 + tid; idx < T * 8; idx += G * 512) { const int t = idx >> 3, i = idx & 7;
              double iv = 1.0;
              iv = (i == 1) ? 0.19392274474868576 : iv; iv = (i == 2) ? 0.03760603093086393 : iv; iv = (i == 3) ? 0.0072926647372171085 : iv; iv = (i == 4) ? 0.0014142135623730952 : iv;
              iv = (i == 5) ? 0.0002742481756762073 : iv; iv = (i == 6) ? 5.318295896944988e-05 : iv; iv = (i == 7) ? 1.0313385377212458e-05 : iv;
              float sn, cn; sincos_d((double)positions[t] * iv, sn, cn); CS[(size_t)t * 16 + i] = cn; CS[(size_t)t * 16 + 8 + i] = sn; } }
        { bf16* WR = (bf16*)(ws + WS_RW);
          for (int idx = vcu * 512 + tid; idx < DEPTH * 80 * D; idx += G * 512) { const int l = idx / (80 * D), rem = idx % (80 * D), n = rem / D, k = rem % D;
              float w = 0.f;
              if (n < 8) w = ((const float*)A->in[11])[((size_t)l * D + k) * 8 + n];
              else if (n < 72) { const int g = (n - 8) >> 3, e = (n - 8) & 7; w = ((const float*)A->in[13])[(((size_t)l * 8 + g) * D + k) * 8 + e]; }
              w *= ((const float*)A->in[10])[l * D + k];
              const unsigned hi = pg8::cvt_pk_bf16_c(w, 0.f) & 0xffffu; const float rest = w - __uint_as_float(hi << 16); const unsigned lo = pg8::cvt_pk_bf16_c(rest, 0.f) & 0xffffu;
              WR[((size_t)(l * 2 + 0) * 80 + n) * D + k] = (bf16)hi; WR[((size_t)(l * 2 + 1) * 80 + n) * D + k] = (bf16)lo; } }
        { const float* x = (const float*)A->in[0]; bf16* NB = (bf16*)(ws + WS_N); const float* g1 = (const float*)A->in[2];
          norm_rows<0>(lane, gw, NGW, x, nullptr, nullptr, g1, NB, (unsigned char*)(ws + WS_N8), nullptr); }
    }
    SEAM(0);

    auto layer_body = [&](auto lc_) { constexpr int l = decltype(lc_)::value;
        const int pb = 1 + l * PH_PER_LAYER;
        if (IN(pb + 0)) {
            PH_LOCALS
            bf16* HB = (bf16*)(ws + WS_H); const unsigned char* SLAB = (const unsigned char*)(ws + WS_U); bf16* NB = (bf16*)(ws + WS_N); const float* g1 = (const float*)A->in[2] + l * D;
            if (l > 0) norm_rows<1>(lane, gw, NGW, nullptr, HB, SLAB, g1, NB, (unsigned char*)(ws + WS_N8), nullptr);
        }
        if (l > 0) SEAM(pb + 0);
        if (IN(pb + 1)) {
            PH_LOCALS
            pg8::Gemm g{(bf16*)(ws + WS_N), (bf16*)(ws + WS_WIN) + (size_t)l * 3072 * D, nullptr}; pg8::StaticOrder<T, 3072> S; S.init(G, bx);
            pg8::EpiInProj<0> E{(bf16*)(ws + WS_U), (bf16*)(ws + WS_CC), (bf16*)(ws + WS_Q), (bf16*)(ws + WS_K), (bf16*)(ws + WS_VT), (bf16*)(ws + WS_G), (const float*)A->in[4] + l * 2048, (const float*)(ws + WS_CS), 1.0f};
            const bool few = (G == 256) && (bx >= 128); const int cfirst = (G == 256) ? (few ? 23552 + (bx - 128) * 8 + wave : bx * 8 + wave) : gw;
            const int cstride = (G == 256) ? 1024 : NGW; const int cend = (G == 256 && !few) ? 23552 : DEPTH * CI_EXP;
            if (l == 0 && (vcu & 1) == 0) { convert_items(A, ws, lds, 1, lane, wave, cfirst, cstride, cend); __syncthreads(); }
            pg8::gemm_phase<pg8::EpiInProj<0>, pg8::StaticOrder<T, 3072>, true, true, false, D>(lds + RING_OFF, tid, g, S, E, nullptr);
            { pg8::Gemm g8{(const pg8::bf16_t*)(ws + WS_N8), (const pg8::bf16_t*)(ws + WS_WIN8 + (size_t)l * 3328 * D), nullptr}; pg8::StaticOrder<T, 3328> S8; S8.init(G, bx);
              pg8::EpiInProj<1> E8{E.U, E.CC, E.Q, E.Kb, E.VT, E.G, E.bgate, E.cs, 1.0f / pg8::WIN8_SCALE};
              pg8::gemm_phase<pg8::EpiInProj<1>, pg8::StaticOrder<T, 3328>, true, true, false, D, false, true>(lds + RING_OFF, tid, g8, S8, E8, nullptr); }
        }
        if (IN(pb + 1) && l == 0) {
            PH_LOCALS
            if ((vcu & 1) == 1) {
                const bool few = (G == 256) && (bx >= 128); const int cfirst = (G == 256) ? (few ? 23552 + (bx - 128) * 8 + wave : bx * 8 + wave) : gw;
                const int cstride = (G == 256) ? 1024 : NGW; const int cend = (G == 256 && !few) ? 23552 : DEPTH * CI_EXP;
                convert_items(A, ws, lds, 1, lane, wave, cfirst, cstride, cend); __syncthreads(); }
        }
        SEAM(pb + 1);
        if (IN(pb + 2)) {
            PH_LOCALS
            const unsigned char* QB = (const unsigned char*)(ws + WS_Q); const bf16* KB = (const bf16*)(ws + WS_K); const bf16* VTB = (const bf16*)(ws + WS_VT);
            unsigned char* OB = (unsigned char*)(ws + WS_O8);
            const float* sinks = (const float*)A->in[6] + l * 16;
            attn_phase(lds, tid, vcu, G, QB, OB, KB, VTB, sinks);
            const float* cw = (const float*)A->in[5] + l * 3 * D;
            if (G == 256) { for (int k = 0; k < 2; ++k) conv_item(tid, (vcu >> 5) * 64 + (vcu & 31) + 32 * k, (const bf16*)(ws + WS_U), (const bf16*)(ws + WS_CC), cw, (bf16*)(ws + WS_N)); }
            else for (int it = vcu; it < T / 64; it += G) conv_item(tid, it, (const bf16*)(ws + WS_U), (const bf16*)(ws + WS_CC), cw, (bf16*)(ws + WS_N));
        }
        SEAM(pb + 2);
        if (IN(pb + 3)) {
            PH_LOCALS
            pg8::Gemm g{(bf16*)(ws + WS_N), (const pg8::bf16_t*)(ws + WS_WC + (size_t)l * D * 3072), (const pg8::bf16_t*)(ws + WS_O8)}; pg8::StaticOrder<T, D> S; S.init(G, bx);
            pg8::EpiGate2 E{(const unsigned char*)(ws + WS_G), (bf16*)(ws + WS_CC)};
            pg8::gemm_phase<pg8::EpiGate2, pg8::StaticOrder<T, D>, true, true, false, 2 * D, true, false, true>(lds + RING_OFF, tid, g, S, E, nullptr);
        }
        SEAM(pb + 4);
        if (IN(pb + 5)) {
            PH_LOCALS
            pg8::Gemm g{(bf16*)(ws + WS_CC), (bf16*)(ws + WS_WO) + (size_t)l * D * D, nullptr}; pg8::StaticOrder<T, D> S; S.init(G, bx);
            pg8::EpiResid E{(l == 0) ? (const float*)A->in[0] : nullptr, (const bf16*)(ws + WS_H), (bf16*)(ws + WS_H), (unsigned char*)(ws + WS_H8)};
            pg8::gemm_phase<pg8::EpiResid, pg8::StaticOrder<T, D>, true, true, false, D>(lds + RING_OFF, tid, g, S, E, nullptr);
        }
        SEAM(pb + 5);
        if (IN(pb + 6)) {
            PH_LOCALS
            unsigned* cnt = (unsigned*)((gu32*)(ws + WS_CTL) + CW_CNT) + l * 64 * 16;
            const float* bg = (const float*)A->in[12] + l * 8; const float* brt = (const float*)A->in[14] + l * 64;
            const bf16* HB = (const bf16*)(ws + WS_H); int* LISTS = (int*)(ws + WS_LIST); float* WTS = (float*)(ws + WS_WTS);
            const bf16* WR = (const bf16*)(ws + WS_RW) + (size_t)l * 2 * 80 * D;
            for (int rb = vcu; rb < T / 128; rb += G) router_block(lds, tid, rb * 128, HB, WR, bg, brt, cnt, LISTS, WTS, (float*)(ws + WS_RSTD));
        }
        SEAM(pb + 6);
#define MOE_PTRS \
        LAS int* tstart = (LAS int*)(lds + TAB_OFF); LAS int* cntL = (LAS int*)(lds + TAB_OFF + 512); \
        LAS int* tokT = (LAS int*)(lds + TOK_OFF); LAS float* wtT = (LAS float*)(lds + WT_OFF); LAS int* tokA = (LAS int*)(lds + TOKA_OFF); LAS float* wtA = (LAS float*)(lds + WTA_OFF); \
        (void)cntL; (void)tokT; (void)wtT; (void)tokA; (void)wtA;
#define MOE_ORDER \
        pg8::MoeOrder S; S.NT4 = __builtin_amdgcn_readfirstlane(tstart[64] * 4); S.G = G; S.c = vcu; S.uexp = (LAS int*)(lds + TAB_OFF + 768);
#define MOE_BUILD \
        { unsigned* cnt = (unsigned*)((gu32*)(ws + WS_CTL) + CW_CNT) + l * 64 * 16; const int* LISTS = (const int*)(ws + WS_LIST); const float* WTS = (const float*)(ws + WS_WTS); const float* RSTD = (const float*)(ws + WS_RSTD); \
          if (tid < 64) { const int c_ = (int)__hip_atomic_load(cnt + tid * 16, RLX_AGENT); cntL[tid] = c_; const int v_ = (c_ + 255) >> 8; int inc_ = v_; \
              _Pragma("unroll") for (int d_ = 1; d_ < 64; d_ *= 2) { const int o_ = __builtin_amdgcn_ds_bpermute(((tid - d_) & 63) * 4, inc_); if (tid >= d_) inc_ += o_; } \
              tstart[tid] = inc_ - v_; if (tid == 63) tstart[64] = inc_; } \
          __syncthreads(); \
          if (tid < MAX_UNITS) { const int mt_ = (tid * G + vcu) >> 2; int e_ = 0; for (int k_ = 1; k_ < 64; ++k_) e_ += (tstart[k_] <= mt_) ? 1 : 0; ((LAS int*)(lds + TAB_OFF + 768))[tid] = e_; } \
          __syncthreads(); \
          MOE_ORDER \
          v4u entv[MAX_UNITS]; \
          _Pragma("unroll") for (int i = 0; i < MAX_UNITS; ++i) { entv[i] = (v4u){0xffffffffu, 0u, 0u, 0u}; pg8::Unit u; if (S.next(i, u) && tid < 256) { const int e = u.pn >> 2; const int idx = (u.pm - tstart[e]) * 256 + tid; \
              if (idx < cntL[e]) entv[i] = ((const GAS v4u*)LISTS)[(size_t)e * LIST_CAP + idx]; } } \
          _Pragma("unroll") for (int i = 0; i < MAX_UNITS; ++i) { if (i * G + vcu < S.NT4 && tid < 256) { const int aid = (int)entv[i].x; const bool valid = aid >= 0; \
              tokT[i * 256 + tid] = valid ? (aid >> 1) : 0; wtT[i * 256 + tid] = valid ? __uint_as_float(entv[i].z) : 0.f; tokA[i * 256 + tid] = aid; wtA[i * 256 + tid] = valid ? __uint_as_float(entv[i].y) : 0.f; } } \
          __syncthreads(); }
        if (IN(pb + 7)) {
            PH_LOCALS
            MOE_PTRS
            MOE_BUILD
            MOE_ORDER
            pg8::Gemm g{(const pg8::bf16_t*)(ws + WS_H8), (const pg8::bf16_t*)(ws + WS_W13 + (size_t)l * NEXP * 1024 * D), nullptr}; pg8::EpiFfn1 E{(unsigned char*)(ws + WS_G), wtT};
            pg8::gemm_phase<pg8::EpiFfn1, pg8::MoeOrder, true, true, true, D, false, true>(lds + RING_OFF, tid, g, S, E, tokT);
        }
        SEAM(pb + 7);
        if (IN(pb + 8)) {
            PH_LOCALS
            MOE_PTRS
            if (MK_PER_PHASE) MOE_BUILD
            MOE_ORDER
            pg8::Gemm g{(const pg8::bf16_t*)(ws + WS_G), (const pg8::bf16_t*)(ws + WS_W2 + (size_t)l * NEXP * D * FF), nullptr}; pg8::EpiFfn2 E{(unsigned char*)(ws + WS_U), tokA, wtA};
            pg8::gemm_phase<pg8::EpiFfn2, pg8::MoeOrder, true, true, false, FF, false, true>(lds + RING_OFF, tid, g, S, E, nullptr);
        }
        SEAM(pb + 8);
#undef MOE_PTRS
#undef MOE_ORDER
#undef MOE_BUILD
    };
    layer_body(LayerTag<0>{}); layer_body(LayerTag<1>{});
    static_assert(DEPTH == 2, "two layers");
    if (IN(N_PHASES - 1)) {
        PH_LOCALS
        bf16* HB = (bf16*)(ws + WS_H); const unsigned char* SLAB = (const unsigned char*)(ws + WS_U);
        norm_rows<2>(lane, gw, NGW, nullptr, HB, SLAB, (const float*)A->in[18], nullptr, nullptr, A->out);
    }
#undef IN
#undef SEAM
#undef PH_LOCALS
#undef MY_TID
#undef HW_SLOT
}

extern "C" void kernel_launch(void* const* d_in, const int* in_sizes, int n_in, void* d_out, int out_size, void* d_ws, size_t ws_size, hipStream_t stream) {
    static int grid = 0;
    if (grid == 0) {
        if (n_in != 19 || out_size != T * D || ws_size < WS_END) { fprintf(stderr, "kernel_launch: unexpected sizes n_in %d out %d ws %zu\n", n_in, out_size, ws_size); grid = -1; return; }
        int dev = 0, cus = 0;
        if (hipGetDevice(&dev) != hipSuccess || hipDeviceGetAttribute(&cus, hipDeviceAttributeMultiprocessorCount, dev) != hipSuccess) { grid = -1; return; }
        if (hipFuncSetAttribute((const void*)fwd_kernel, hipFuncAttributeMaxDynamicSharedMemorySize, LDS_BYTES) != hipSuccess) { fprintf(stderr, "kernel_launch: hipFuncSetAttribute failed\n"); grid = -1; return; }
        (void)hipGetLastError();
        grid = cus;
    }
    if (grid < 0) return;
    if (hipMemsetAsync((char*)d_ws + WS_CTL, 0, CTL_ZERO_BYTES, stream) != hipSuccess) return;
    Args a{};
    for (int i = 0; i < 19; ++i) a.in[i] = d_in[i];
    a.out = (float*)d_out; a.ws = (unsigned char*)d_ws;
#if MK_PER_PHASE
    for (int p = 0; p < N_PHASES; ++p) { a.ph_lo = p; a.ph_hi = p + 1; hipLaunchKernelGGL(fwd_kernel, dim3(grid), dim3(NWAVES * 64), LDS_BYTES, stream, a); }

#else
    a.ph_lo = 0; a.ph_hi = N_PHASES;
    hipLaunchKernelGGL(fwd_kernel, dim3(grid), dim3(NWAVES * 64), LDS_BYTES, stream, a);
#endif
}
```

```cpp
#include <hip/hip_runtime.h>
#include <cstdio>
#include <cstdint>

#ifndef MK_PER_PHASE
#define MK_PER_PHASE 0
#endif

constexpr int BATCH = 4, SEQ = 8192, D = 1024, T = BATCH * SEQ, DEPTH = 2;
constexpr int IN_COLS = 6400, NKV = 2, HD = 64, CHUNK = 64;
constexpr int NEXP = 64, FF = 512;
constexpr float RMS_EPS = 1e-5f;
constexpr float C2 = 0.125f * 1.4426950408889634f;
constexpr float LOG2E = 1.4426950408889634f;
constexpr int LIST_CAP = T;
constexpr int MAX_UNITS = 6;

namespace pg8 {
#define PG8_LAS __attribute__((address_space(3)))
typedef unsigned short bf16_t;
typedef short bf16x8 __attribute__((ext_vector_type(8)));
typedef float f32x4 __attribute__((ext_vector_type(4)));
typedef unsigned u32x4 __attribute__((ext_vector_type(4)));
typedef unsigned u32x2 __attribute__((ext_vector_type(2)));
typedef int v4i32 __attribute__((ext_vector_type(4)));
constexpr int BM = 256, BK = 64, HALF = 128, HTB = HALF * BK * 2, STAGE_BYTES = 8 * HTB, NXCD = 8, WGM = 4;

__host__ __device__ __forceinline__ int lds_byte(int r, int c) { const int st = (r >> 4) * 2 + (c >> 5), rr = r & 15, cc = c & 31, ob = rr * 64 + cc * 2; return st * 1024 + (ob ^ (((ob >> 9) & 1) << 5)); }
__host__ __device__ __forceinline__ void stage_rc(int b, int& R, int& C) { const int st = b / 1024, sb = b % 1024, swz = sb ^ (((sb >> 9) & 1) << 5); R = (st >> 1) * 16 + swz / 64; C = (st & 1) * 32 + (swz % 64) / 2; }
__host__ __device__ __forceinline__ int perm32(int rho) { const int n = rho >> 4, i = rho & 15; return 8 * (i >> 2) + 4 * n + (i & 3); }

__device__ __forceinline__ int lane_volatile() { int l; asm volatile("v_mbcnt_lo_u32_b32 %0, -1, 0\n\tv_mbcnt_hi_u32_b32 %0, -1, %0" : "=v"(l)); return l; }
struct Unit { int pm, pn; };
struct Gemm { const bf16_t* A; const bf16_t* Bt; const bf16_t* A2; };

template <int M_, int N_, int WG_ = WGM, bool REV_ = false> struct StaticOrder {
    static constexpr int nM = M_ / BM, nN = N_ / BM, nwg = nM * nN; int G, c;
    __host__ __device__ void init(int G_, int c_) { G = G_; c = c_; }
    __host__ __device__ bool next(int i, Unit& u) const {
        const long L = (long)i * G + c; if (L >= nwg) return false;
        int wgid = (int)L; { const int q = nwg / NXCD, r = nwg % NXCD, xcd = wgid % NXCD, off = wgid / NXCD; wgid = (xcd < r ? xcd * (q + 1) : r * (q + 1) + (xcd - r) * q) + off; }
        const int nig = WG_ * nN, gid = wgid / nig, fm = gid * WG_, gsz = (nM - fm) < WG_ ? (nM - fm) : WG_;
        u.pm = fm + ((wgid % nig) % gsz); u.pn = (wgid % nig) / gsz; if (REV_) u.pm = (u.pm & ~15) | (15 - (u.pm & 15)); return true;
    }
};
struct MoeOrder {
    int NT4, G, c; const PG8_LAS int* uexp;
    __device__ __forceinline__ bool next(int i, Unit& u) const {
        const int L = i * G + c; if (L >= NT4) return false;
        u.pm = L >> 2; u.pn = __builtin_amdgcn_readfirstlane(uexp[i]) * 4 + (L & 3); return true;
    }
};

typedef float f32x2_t __attribute__((ext_vector_type(2))); typedef __bf16 bf16x2_t __attribute__((ext_vector_type(2)));
__device__ __forceinline__ unsigned cvt_pk_bf16(float lo, float hi) { unsigned r; asm volatile("s_nop 0\n\tv_cvt_pk_bf16_f32 %0, %1, %2" : "=v"(r) : "v"(lo), "v"(hi)); return r; }
__device__ __forceinline__ unsigned cvt_pk_bf16_c(float lo, float hi) { f32x2_t v = {lo, hi}; bf16x2_t b = __builtin_convertvector(v, bf16x2_t); return __builtin_bit_cast(unsigned, b); }
__device__ __forceinline__ float bf_lo(unsigned w) { return __uint_as_float(w << 16); }
__device__ __forceinline__ float bf_hi(unsigned w) { return __uint_as_float(w & 0xffff0000u); }
__device__ __forceinline__ u32x2 pack8_f8(const f32x4 a, const f32x4 b) { int w0 = __builtin_bit_cast(int, a[0]), w1 = __builtin_bit_cast(int, b[0]);
    w0 = __builtin_amdgcn_cvt_pk_fp8_f32(a[0], a[1], w0, false); w0 = __builtin_amdgcn_cvt_pk_fp8_f32(a[2], a[3], w0, true);
    w1 = __builtin_amdgcn_cvt_pk_fp8_f32(b[0], b[1], w1, false); w1 = __builtin_amdgcn_cvt_pk_fp8_f32(b[2], b[3], w1, true);
    u32x2 r; r.x = (unsigned)w0; r.y = (unsigned)w1; return r; }
constexpr float W13_SCALE = 32.0f, W2_SCALE = 16.0f, SLAB_SCALE = 16.0f, WA_SCALE = 32.0f, WIN8_SCALE = 32.0f, Q8_SCALE = 8.0f;
__device__ __forceinline__ u32x4 pack8c(const f32x4 a, const f32x4 b) { u32x4 w; w.x = cvt_pk_bf16_c(a[0], a[1]); w.y = cvt_pk_bf16_c(a[2], a[3]); w.z = cvt_pk_bf16_c(b[0], b[1]); w.w = cvt_pk_bf16_c(b[2], b[3]); return w; }
__device__ __forceinline__ u32x4 pack8(const f32x4 a, const f32x4 b) { u32x4 w; w.x = cvt_pk_bf16(a[0], a[1]); w.y = cvt_pk_bf16(a[2], a[3]); w.z = cvt_pk_bf16(b[0], b[1]); w.w = cvt_pk_bf16(b[2], b[3]); return w; }

typedef unsigned bu32x4_t __attribute__((__vector_size__(16))); typedef unsigned bu32x2_t __attribute__((__vector_size__(8)));
typedef f32x4 Acc[2][2][4][2];
__device__ __forceinline__ f32x4 zero4_asm() { float a, b, c, d; asm volatile("v_mov_b32 %0, 0\n\tv_mov_b32 %1, 0\n\tv_mov_b32 %2, 0\n\tv_mov_b32 %3, 0" : "=v"(a), "=v"(b), "=v"(c), "=v"(d)); return (f32x4){a, b, c, d}; }

template <int MODE> struct EpiInProj {
    bf16_t *U, *CC, *Q, *Kb, *VT, *G; const float* bgate; const float* cs; float sc;
    __device__ __forceinline__ void operator()(const Acc& acc, const Unit& u, int ui, int wr, int wc, int fr, int fq) const {
        const int pn = MODE ? 12 + u.pn : u.pn; const int row0 = u.pm * BM + wr * 64 + fr; const int cw = wc * 32 + 8 * fq;
        if (MODE == 0 && pn < 8) {
#pragma unroll
            for (int ai = 0; ai < 2; ++ai)
#pragma unroll
                for (int m = 0; m < 4; ++m) { const size_t row = row0 + ai * HALF + m * 16;
                    *(u32x4*)(U + row * D + pn * 128 + cw) = pack8(acc[ai][0][m][0] * acc[ai][1][m][0], acc[ai][0][m][1] * acc[ai][1][m][1]); }
        } else if (MODE == 0) {
#pragma unroll
            for (int ai = 0; ai < 2; ++ai)
#pragma unroll
                for (int m = 0; m < 4; ++m) { const size_t row = row0 + ai * HALF + m * 16;
#pragma unroll
                    for (int bj = 0; bj < 2; ++bj) *(u32x4*)(CC + row * D + (pn - 8) * 256 + bj * HALF + cw) = pack8c(acc[ai][bj][m][0], acc[ai][bj][m][1]); }
        } else if (pn < 16) {
            const bool rot = ((wc & 1) == 0) && (fq < 2);
#pragma unroll
            for (int ai = 0; ai < 2; ++ai) {
                f32x4 cv[4], sv[4];
#pragma unroll
                for (int m = 0; m < 4; ++m) { cv[m] = (f32x4){1.f, 1.f, 1.f, 1.f}; sv[m] = (f32x4){0.f, 0.f, 0.f, 0.f}; }
                if (rot) {
#pragma unroll
                    for (int m = 0; m < 4; ++m) { const size_t row = row0 + ai * HALF + m * 16; cv[m] = *(const f32x4*)(cs + row * 16 + 4 * fq); sv[m] = *(const f32x4*)(cs + row * 16 + 8 + 4 * fq); } }
#pragma unroll
                for (int m = 0; m < 4; ++m) { const size_t row = row0 + ai * HALF + m * 16;
                    const f32x4 c4 = cv[m], s4 = sv[m];
#pragma unroll
                    for (int bj = 0; bj < 2; ++bj) { f32x4 a = acc[ai][bj][m][0] * sc, b = acc[ai][bj][m][1] * sc;
                        f32x4 ra = {a[0] * c4[0] - a[1] * s4[0], a[1] * c4[0] + a[0] * s4[0], a[2] * c4[1] - a[3] * s4[1], a[3] * c4[1] + a[2] * s4[1]};
                        f32x4 rb = {b[0] * c4[2] - b[1] * s4[2], b[1] * c4[2] + b[0] * s4[2], b[2] * c4[3] - b[3] * s4[3], b[3] * c4[3] + b[2] * s4[3]};
                        *(u32x2*)((unsigned char*)Q + row * D + (pn - 12) * 256 + bj * HALF + cw) = pack8_f8(ra * (C2 * Q8_SCALE), rb * (C2 * Q8_SCALE)); }
                    asm volatile("" ::: "memory"); __builtin_amdgcn_sched_barrier(0); } }
        } else if (pn == 16) {
            const bool rot = ((wc & 1) == 0) && (fq < 2);
#pragma unroll
            for (int ai = 0; ai < 2; ++ai) {
                f32x4 cv[4], sv[4];
#pragma unroll
                for (int m = 0; m < 4; ++m) { cv[m] = (f32x4){1.f, 1.f, 1.f, 1.f}; sv[m] = (f32x4){0.f, 0.f, 0.f, 0.f}; }
                if (rot) {
#pragma unroll
                    for (int m = 0; m < 4; ++m) { const size_t row = row0 + ai * HALF + m * 16; cv[m] = *(const f32x4*)(cs + row * 16 + 4 * fq); sv[m] = *(const f32x4*)(cs + row * 16 + 8 + 4 * fq); } }
#pragma unroll
                for (int m = 0; m < 4; ++m) { const size_t row = row0 + ai * HALF + m * 16;
                    const f32x4 c4 = cv[m], s4 = sv[m];
                    { f32x4 a = acc[ai][0][m][0] * sc, b = acc[ai][0][m][1] * sc;
                      f32x4 ra = {a[0] * c4[0] - a[1] * s4[0], a[1] * c4[0] + a[0] * s4[0], a[2] * c4[1] - a[3] * s4[1], a[3] * c4[1] + a[2] * s4[1]};
                      f32x4 rb = {b[0] * c4[2] - b[1] * s4[2], b[1] * c4[2] + b[0] * s4[2], b[2] * c4[3] - b[3] * s4[3], b[3] * c4[3] + b[2] * s4[3]};
                      *(u32x4*)(Kb + row * 128 + cw) = pack8(ra, rb); }
                    { const int b_ = (int)(row >> 13), s_ = (int)(row & 8191); const int kh = wc >> 1, d0 = 32 * (wc & 1) + 8 * fq;
                      bf16_t* vp = VT + ((size_t)((b_ * 2 + kh) * 64 + d0)) * SEQ + s_;
#pragma unroll
                      for (int n = 0; n < 2; ++n)
#pragma unroll
                          for (int j = 0; j < 4; ++j) { const unsigned w = cvt_pk_bf16_c(acc[ai][1][m][n][j] * sc, 0.f); vp[(size_t)(4 * n + j) * SEQ] = (bf16_t)(w & 0xffffu); } } } }
        } else {
            const int gc0 = (pn - 17) * 256 + cw;
            f32x4 bv[2][2];
#pragma unroll
            for (int bj = 0; bj < 2; ++bj)
#pragma unroll
                for (int n = 0; n < 2; ++n) bv[bj][n] = *(const f32x4*)(bgate + gc0 + bj * HALF + 4 * n);
#pragma unroll
            for (int ai = 0; ai < 2; ++ai)
#pragma unroll
                for (int m = 0; m < 4; ++m) { const size_t row = row0 + ai * HALF + m * 16;
#pragma unroll
                    for (int bj = 0; bj < 2; ++bj) { f32x4 v[2];
#pragma unroll
                        for (int n = 0; n < 2; ++n) { const f32x4 x = acc[ai][bj][m][n] * sc + bv[bj][n];
#pragma unroll
                            for (int j = 0; j < 4; ++j) v[n][j] = __builtin_rintf(255.0f * __builtin_amdgcn_rcpf(1.0f + __builtin_amdgcn_exp2f(-LOG2E * x[j]))); }
                        u32x2 w; w.x = 0u; w.y = 0u;
#pragma unroll
                        for (int j = 0; j < 4; ++j) { w.x = __builtin_amdgcn_cvt_pk_u8_f32(v[0][j], j, w.x); w.y = __builtin_amdgcn_cvt_pk_u8_f32(v[1][j], j, w.y); }
                        *(u32x2*)((unsigned char*)G + row * 2048 + gc0 + bj * HALF) = w; } }
        }
    }
};
template <bool ADD> struct EpiGate {
    const bf16_t* G; int gcol0; const bf16_t* addend; bf16_t* O;
    __device__ __forceinline__ void operator()(const Acc& acc, const Unit& u, int ui, int wr, int wc, int fr, int fq) const {
        const int row0 = u.pm * BM + wr * 64 + fr; const int col0 = u.pn * BM + wc * 32 + 8 * fq;
#pragma unroll
        for (int ai = 0; ai < 2; ++ai) {
            u32x2 gv[4][2]; u32x4 tv[4][2];
#pragma unroll
            for (int m = 0; m < 4; ++m)
#pragma unroll
                for (int bj = 0; bj < 2; ++bj) { const size_t row = row0 + ai * HALF + m * 16; const int col = col0 + bj * HALF;
                    gv[m][bj] = *(const u32x2*)((const unsigned char*)G + row * 2048 + gcol0 + col);
                    if (ADD) tv[m][bj] = *(const u32x4*)(addend + row * D + col); }
#pragma unroll
            for (int m = 0; m < 4; ++m)
#pragma unroll
                for (int bj = 0; bj < 2; ++bj) { const size_t row = row0 + ai * HALF + m * 16; const int col = col0 + bj * HALF;
                    const u32x2 g = gv[m][bj]; constexpr float Q = 1.0f / 255.0f;
                    f32x4 a = acc[ai][bj][m][0], b = acc[ai][bj][m][1];
                    a = a * ((f32x4){(float)(g.x & 0xffu), (float)((g.x >> 8) & 0xffu), (float)((g.x >> 16) & 0xffu), (float)(g.x >> 24)} * Q);
                    b = b * ((f32x4){(float)(g.y & 0xffu), (float)((g.y >> 8) & 0xffu), (float)((g.y >> 16) & 0xffu), (float)(g.y >> 24)} * Q);
                    if (ADD) { const u32x4 t = tv[m][bj];
                        a = a + (f32x4){bf_lo(t.x), bf_hi(t.x), bf_lo(t.y), bf_hi(t.y)}; b = b + (f32x4){bf_lo(t.z), bf_hi(t.z), bf_lo(t.w), bf_hi(t.w)}; }
                    *(u32x4*)(O + row * D + col) = pack8(a, b); }
        }
    }
};
struct EpiGate2 {
    const unsigned char* G8; bf16_t* O;
    __device__ __forceinline__ void mid(Acc& acc, const Unit& u, int wr, int wc, int fr, int fq) const {
        const auto rG = __builtin_amdgcn_make_buffer_rsrc((void*)G8, 0, 0xffffffff, 0x00020000);
        int vo = (u.pm * BM + wr * 64 + fr) * 2048 + u.pn * BM + wc * 32 + 8 * fq;
        asm volatile("" : "+v"(vo) :: "memory");
#pragma unroll
        for (int ai = 0; ai < 2; ++ai) {
            u32x2 gc[4][2], ga[4][2];
#pragma unroll
            for (int m = 0; m < 4; ++m)
#pragma unroll
                for (int bj = 0; bj < 2; ++bj) {
                    gc[m][bj] = __builtin_bit_cast(u32x2, __builtin_amdgcn_raw_buffer_load_b64(rG, vo + bj * HALF, (ai * HALF + m * 16) * 2048, 0));
                    ga[m][bj] = __builtin_bit_cast(u32x2, __builtin_amdgcn_raw_buffer_load_b64(rG, vo + bj * HALF + 1024, (ai * HALF + m * 16) * 2048, 0)); }
#pragma unroll
            for (int m = 0; m < 4; ++m)
#pragma unroll
                for (int bj = 0; bj < 2; ++bj)
#pragma unroll
                    for (int n = 0; n < 2; ++n) { const unsigned c = n ? gc[m][bj].y : gc[m][bj].x, a = n ? ga[m][bj].y : ga[m][bj].x;
#pragma unroll
                        for (int j = 0; j < 4; ++j) { const float qc = (float)((c >> (8 * j)) & 0xffu), qa = fmaxf((float)((a >> (8 * j)) & 0xffu), 1.0f);
                            acc[ai][bj][m][n][j] *= (WA_SCALE * qc) * __builtin_amdgcn_rcpf(qa); } }
            asm volatile("" ::: "memory"); __builtin_amdgcn_sched_barrier(0);
        }
    }
    __device__ __forceinline__ void operator()(const Acc& acc, const Unit& u, int ui, int wr, int wc, int fr, int fq) const {
        const auto rG = __builtin_amdgcn_make_buffer_rsrc((void*)G8, 0, 0xffffffff, 0x00020000);
        int row0 = u.pm * BM + wr * 64 + fr; const int col0 = u.pn * BM + wc * 32 + 8 * fq;
        asm volatile("" : "+v"(row0));
        const int vo = row0 * 2048 + col0 + 1024;
        u32x2 ga[2][4][2];
#pragma unroll
        for (int ai = 0; ai < 2; ++ai)
#pragma unroll
            for (int m = 0; m < 4; ++m)
#pragma unroll
                for (int bj = 0; bj < 2; ++bj) ga[ai][m][bj] = __builtin_bit_cast(u32x2, __builtin_amdgcn_raw_buffer_load_b64(rG, vo + bj * HALF, (ai * HALF + m * 16) * 2048, 0));
#pragma unroll
        for (int ai = 0; ai < 2; ++ai)
#pragma unroll
            for (int m = 0; m < 4; ++m)
#pragma unroll
                for (int bj = 0; bj < 2; ++bj) { const u32x2 g = ga[ai][m][bj]; constexpr float Q = 1.0f / (255.0f * WA_SCALE); f32x4 v[2];
#pragma unroll
                    for (int n = 0; n < 2; ++n) { const unsigned a = n ? g.y : g.x;
#pragma unroll
                        for (int j = 0; j < 4; ++j) v[n][j] = acc[ai][bj][m][n][j] * (fmaxf((float)((a >> (8 * j)) & 0xffu), 1.0f) * Q); }
                    *(u32x4*)(O + (size_t)(row0 + ai * HALF + m * 16) * D + col0 + bj * HALF) = pack8(v[0], v[1]); }
    }
};
struct EpiResid {
    const float* Xin; const bf16_t* Hin16; bf16_t* Hout; unsigned char* H8;
    __device__ __forceinline__ void operator()(const Acc& acc, const Unit& u, int ui, int wr, int wc, int fr, int fq) const {
        const int row0 = u.pm * BM + wr * 64 + fr; const int col0 = u.pn * BM + wc * 32 + 8 * fq;
        if (Xin) {
#pragma unroll
            for (int ai = 0; ai < 2; ++ai)
#pragma unroll
                for (int mh = 0; mh < 2; ++mh) {
                    f32x4 hv[2][2][2];
#pragma unroll
                    for (int mm = 0; mm < 2; ++mm)
#pragma unroll
                        for (int bj = 0; bj < 2; ++bj) { const size_t o = (size_t)(row0 + ai * HALF + (2 * mh + mm) * 16) * D + col0 + bj * HALF;
                            hv[mm][bj][0] = *(const f32x4*)(Xin + o); hv[mm][bj][1] = *(const f32x4*)(Xin + o + 4); }
#pragma unroll
                    for (int mm = 0; mm < 2; ++mm)
#pragma unroll
                        for (int bj = 0; bj < 2; ++bj) { const int m = 2 * mh + mm; const size_t o = (size_t)(row0 + ai * HALF + m * 16) * D + col0 + bj * HALF;
                            const f32x4 r0 = hv[mm][bj][0] + acc[ai][bj][m][0], r1 = hv[mm][bj][1] + acc[ai][bj][m][1];
                            *(u32x4*)(Hout + o) = pack8(r0, r1); *(u32x2*)(H8 + o) = pack8_f8(r0, r1); }
                }
        } else {
#pragma unroll
            for (int ai = 0; ai < 2; ++ai) {
                u32x4 hv[4][2];
#pragma unroll
                for (int m = 0; m < 4; ++m)
#pragma unroll
                    for (int bj = 0; bj < 2; ++bj) hv[m][bj] = *(const u32x4*)(Hin16 + (size_t)(row0 + ai * HALF + m * 16) * D + col0 + bj * HALF);
#pragma unroll
                for (int m = 0; m < 4; ++m)
#pragma unroll
                    for (int bj = 0; bj < 2; ++bj) { const size_t o = (size_t)(row0 + ai * HALF + m * 16) * D + col0 + bj * HALF; const u32x4 t = hv[m][bj];
                        const f32x4 r0 = (f32x4){bf_lo(t.x), bf_hi(t.x), bf_lo(t.y), bf_hi(t.y)} + acc[ai][bj][m][0], r1 = (f32x4){bf_lo(t.z), bf_hi(t.z), bf_lo(t.w), bf_hi(t.w)} + acc[ai][bj][m][1];
                        *(u32x4*)(Hout + o) = pack8(r0, r1); *(u32x2*)(H8 + o) = pack8_f8(r0, r1); }
            }
        }
    }
};
struct EpiFfn1 {
    unsigned char* HID8; const PG8_LAS float* rs;
    __device__ __forceinline__ void operator()(const Acc& acc, const Unit& u, int ui, int wr, int wc, int fr, int fq) const {
        const int row0 = u.pm * BM + wr * 64 + fr; const int col0 = (u.pn & 3) * 128 + wc * 32 + 8 * fq;
#pragma unroll
        for (int ai = 0; ai < 2; ++ai)
#pragma unroll
            for (int m = 0; m < 4; ++m) { const size_t row = row0 + ai * HALF + m * 16; f32x4 v[2]; const float r = rs[ui * 256 + ai * HALF + wr * 64 + m * 16 + fr] * (1.0f / W13_SCALE);
#pragma unroll
                for (int n = 0; n < 2; ++n)
#pragma unroll
                    for (int j = 0; j < 4; ++j) { const float x = acc[ai][0][m][n][j] * r; v[n][j] = x * __builtin_amdgcn_rcpf(1.0f + __builtin_amdgcn_exp2f(-LOG2E * x)) * (acc[ai][1][m][n][j] * r); }
                *(u32x2*)(HID8 + row * FF + col0) = pack8_f8(v[0], v[1]); }
    }
};
struct EpiFfn2 {
    unsigned char* SLAB; const PG8_LAS int* aid; const PG8_LAS float* wt;
    __device__ __forceinline__ void operator()(const Acc& acc, const Unit& u, int ui, int wr, int wc, int fr, int fq) const {
        const int col0 = (u.pn & 3) * BM + wc * 32 + 8 * fq;
#pragma unroll
        for (int ai = 0; ai < 2; ++ai)
#pragma unroll
            for (int m = 0; m < 4; ++m) { const int rl = ai * HALF + wr * 64 + m * 16 + fr; const int a = aid[ui * 256 + rl]; const float w = wt[ui * 256 + rl] * (SLAB_SCALE / W2_SCALE);
                if (a >= 0) {
#pragma unroll
                    for (int bj = 0; bj < 2; ++bj) *(u32x2*)(SLAB + (size_t)a * D + col0 + bj * HALF) = pack8_f8(acc[ai][bj][m][0] * w, acc[ai][bj][m][1] * w); } }
    }
};

template <class Epi, class Sched, bool ALIGN_EPI, bool SP2, bool GATHER, int KDIM, bool DUALA = false, bool F8 = false, bool MIXED = false>
__device__ __forceinline__ void gemm_phase(PG8_LAS unsigned char* lds, const int tid, const Gemm g, const Sched& S, const Epi& E, const PG8_LAS int* tokTab) {
    static_assert(SP2 && (!MIXED || (DUALA && !F8 && !GATHER)), "two super-phases per K-tile; MIXED needs DUALA");
    const int wid = __builtin_amdgcn_readfirstlane(tid >> 6), lane = tid & 63, wr = wid >> 2, wc = wid & 3, fr = lane & 15, fq = lane >> 4;
    constexpr int ESZ = F8 ? 1 : 2, K = KDIM, NTB = 16, nt = MIXED ? 24 : K * ESZ / 128, MIDT = MIXED ? NTB : nt / 2;
    constexpr unsigned AROW = MIXED ? 2048u : (unsigned)((DUALA ? K / 2 : K) * ESZ), AROWF = 1024u, BROW = MIXED ? 3072u : (unsigned)(K * ESZ);
    unsigned voffA[2], voffAF[2], voffB[2];
#pragma unroll
    for (int i = 0; i < 2; ++i) { int R, C; stage_rc(tid * 16 + i * 8192, R, C); const int Rb = (R & ~31) + perm32(R & 31);
        voffA[i] = (unsigned)R * AROW + (unsigned)(C * 2); voffAF[i] = (unsigned)R * AROWF + (unsigned)(C * 2); voffB[i] = (unsigned)Rb * BROW + (unsigned)(C * 2); }
    constexpr unsigned kstep = (unsigned)(BK * 2);
    constexpr unsigned hstep = (unsigned)HALF * BROW, tstep = 2 * hstep;
    constexpr unsigned hstepA = (unsigned)HALF * AROW, tstepA = 2 * hstepA, hstepAF = (unsigned)HALF * AROWF, tstepAF = 2 * hstepAF;
    const unsigned ldsw = (unsigned)wid * 1024u;
    const int aoffB = lds_byte(wr * 64 + fr, fq * 8), boffB = lds_byte(wc * 32 + fr, fq * 8);
    const int aoffF = lds_byte(wr * 64 + fr, (fq & 1) * 16) + (fq >> 1) * 1024, boffF = lds_byte(wc * 32 + fr, (fq & 1) * 16) + (fq >> 1) * 1024;
    unsigned gA[2][2];
    const auto rA = __builtin_amdgcn_make_buffer_rsrc((void*)g.A, 0, 0xffffffff, 0x00020000);
    const auto rB = __builtin_amdgcn_make_buffer_rsrc((void*)g.Bt, 0, 0xffffffff, 0x00020000);
    const unsigned dA2 = DUALA ? (unsigned)((const char*)g.A2 - (const char*)g.A) : 0u;
#define PG8_SA(b, h) (((b) * 2 + (h)) * HTB)
#define PG8_SB(b, h) ((4 + (b) * 2 + (h)) * HTB)
#define PG8_DMA(rsrc, vo, so, ldsoff) __builtin_amdgcn_raw_ptr_buffer_load_lds(rsrc, (PG8_LAS unsigned*)(lds + (ldsoff)), 16, (vo), (so), 0, 0)
#define PG8_STAGE_B(bufoff, so) do { _Pragma("unroll") for (int _i = 0; _i < 2; ++_i) PG8_DMA(rB, voffB[_i], (so), (bufoff) + ldsw + _i * 8192); } while (0)
#define PG8_STAGE_A(bufoff, so, h, isf) do { _Pragma("unroll") for (int _i = 0; _i < 2; ++_i) { \
        if constexpr (GATHER) PG8_DMA(rA, gA[h][_i], (so), (bufoff) + ldsw + _i * 8192); \
        else if constexpr (MIXED) PG8_DMA(rA, (isf) ? voffAF[_i] : voffA[_i], (so) + (h) * ((isf) ? hstepAF : hstepA), (bufoff) + ldsw + _i * 8192); \
        else PG8_DMA(rA, voffA[_i], (so) + (h) * hstepA, (bufoff) + ldsw + _i * 8192); } } while (0)
#define PG8_LDA(dst, b, h, FX) do { _Pragma("unroll") for (int m = 0; m < 4; ++m) _Pragma("unroll") for (int k = 0; k < 2; ++k) dst[m][k] = *(const PG8_LAS bf16x8*)(lds + PG8_SA(b, h) + ((FX) ? aoffF : aoffB) + m * 2048 + k * ((FX) ? 16 : 1024)); } while (0)
#define PG8_LDB(dst, b, h, FX) do { _Pragma("unroll") for (int n = 0; n < 2; ++n) _Pragma("unroll") for (int k = 0; k < 2; ++k) dst[n][k] = *(const PG8_LAS bf16x8*)(lds + PG8_SB(b, h) + ((FX) ? boffF : boffB) + n * 2048 + k * ((FX) ? 16 : 1024)); } while (0)
#define PG8_F8OP(x) __builtin_shufflevector(__builtin_bit_cast(v4i32, x[0]), __builtin_bit_cast(v4i32, x[1]), 0, 1, 2, 3, 4, 5, 6, 7)
#define PG8_MMA(ai, bj, At, Bt, FX) do { __builtin_amdgcn_s_setprio(1); _Pragma("unroll") for (int m = 0; m < 4; ++m) _Pragma("unroll") for (int n = 0; n < 2; ++n) { \
        if constexpr (FX) acc[ai][bj][m][n] = __builtin_amdgcn_mfma_scale_f32_16x16x128_f8f6f4(PG8_F8OP(Bt[n]), PG8_F8OP(At[m]), acc[ai][bj][m][n], 0, 0, 0, 0x7f7f7f7f, 0, 0x7f7f7f7f); \
        else { _Pragma("unroll") for (int k = 0; k < 2; ++k) acc[ai][bj][m][n] = __builtin_amdgcn_mfma_f32_16x16x32_bf16(Bt[n][k], At[m][k], acc[ai][bj][m][n], 0, 0, 0); } } \
        __builtin_amdgcn_s_setprio(0); } while (0)
#define PG8_WAIT_V(n) asm volatile("s_waitcnt vmcnt(" #n ")" ::: "memory")
#define PG8_WAIT_L(n) asm volatile("s_waitcnt lgkmcnt(" #n ")" ::: "memory")
#define PG8_BAR __builtin_amdgcn_s_barrier()
#define PG8_SCHED __builtin_amdgcn_sched_barrier(0)
#define PG8_GLOAD(dst, ui_) do { int _R, _C; stage_rc(tid * 16, _R, _C); _Pragma("unroll") for (int _h = 0; _h < 2; ++_h) _Pragma("unroll") for (int _i = 0; _i < 2; ++_i) \
        dst[_h][_i] = (unsigned)tokTab[(ui_) * 256 + _h * HALF + _R + 64 * _i] * (unsigned)(K * ESZ) + (unsigned)(_C * 2); } while (0)
    Unit cur, nxt; int ui = 0;
    if (!S.next(0, cur)) return;
    f32x4 acc[2][2][4][2];
#pragma unroll
    for (int a = 0; a < 2; ++a)
#pragma unroll
        for (int b = 0; b < 2; ++b)
#pragma unroll
            for (int m = 0; m < 4; ++m)
#pragma unroll
                for (int n = 0; n < 2; ++n) { acc[a][b][m][n] = zero4_asm(); }
    bf16x8 At[4][2], B0[2][2], B1[2][2];
    unsigned cA = GATHER ? 0u : (unsigned)cur.pm * tstepA, cB = (unsigned)cur.pn * tstep;
    unsigned cA2 = DUALA ? dA2 + (unsigned)cur.pm * (MIXED ? tstepAF : tstepA) : 0u;
#define PG8_AOFF(kt) ((DUALA && (kt) >= MIDT) ? cA2 + (unsigned)((kt) - MIDT) * kstep : cA + (unsigned)(kt) * kstep)
    if constexpr (GATHER) { PG8_GLOAD(gA, 0); }
    PG8_STAGE_B(PG8_SB(0, 0), cB); PG8_STAGE_B(PG8_SB(0, 1), cB + hstep); PG8_STAGE_A(PG8_SA(0, 0), cA, 0, false); PG8_STAGE_A(PG8_SA(0, 1), cA, 1, false);
    if (wr == 1) PG8_BAR;
    PG8_WAIT_V(2); PG8_BAR;
    PG8_STAGE_B(PG8_SB(1, 0), cB + kstep); PG8_STAGE_A(PG8_SA(1, 0), cA + kstep, 0, false); PG8_STAGE_B(PG8_SB(1, 1), cB + hstep + kstep);
    PG8_WAIT_V(6); PG8_BAR;
    for (;;) {
        const bool has_next = S.next(ui + 1, nxt);
        const unsigned nA = GATHER ? 0u : (has_next ? (unsigned)nxt.pm * tstepA : cA), nB = has_next ? (unsigned)nxt.pn * tstep : cB;
        const unsigned nA2 = DUALA ? (has_next ? dA2 + (unsigned)nxt.pm * (MIXED ? tstepAF : tstepA) : cA2) : 0u;
#define PG8_TRIP(FX) do { \
            PG8_LDB(B0, 0, 0, FX); PG8_LDB(B1, 0, 1, FX); PG8_SCHED; PG8_LDA(At, 0, 0, FX); PG8_STAGE_A(PG8_SA(1, 1), a1, 1, f1); \
            if constexpr (GATHER) { if (last && has_next) { PG8_GLOAD(gA, ui + 1); } } \
            PG8_WAIT_V(8); PG8_WAIT_L(0); PG8_BAR; PG8_MMA(0, 0, At, B0, FX); PG8_MMA(0, 1, At, B1, FX); PG8_BAR; PG8_SCHED; \
            PG8_LDA(At, 0, 1, FX); PG8_STAGE_B(PG8_SB(0, 0), b2); PG8_STAGE_B(PG8_SB(0, 1), b2 + hstep); PG8_STAGE_A(PG8_SA(0, 0), a2, 0, f2); \
            PG8_WAIT_V(8); PG8_WAIT_L(0); PG8_BAR; PG8_MMA(1, 0, At, B0, FX); PG8_MMA(1, 1, At, B1, FX); PG8_BAR; PG8_SCHED; \
            PG8_LDB(B0, 1, 0, FX); PG8_LDB(B1, 1, 1, FX); PG8_SCHED; PG8_LDA(At, 1, 0, FX); PG8_STAGE_A(PG8_SA(0, 1), a2, 1, f2); \
            PG8_WAIT_V(8); PG8_WAIT_L(0); PG8_BAR; PG8_MMA(0, 0, At, B0, FX); PG8_MMA(0, 1, At, B1, FX); PG8_BAR; PG8_SCHED; \
            PG8_LDA(At, 1, 1, FX); PG8_STAGE_B(PG8_SB(1, 0), b3); PG8_STAGE_B(PG8_SB(1, 1), b3 + hstep); PG8_STAGE_A(PG8_SA(1, 0), a3, 0, f2); \
            PG8_WAIT_V(8); PG8_WAIT_L(0); PG8_BAR; PG8_MMA(1, 0, At, B0, FX); PG8_MMA(1, 1, At, B1, FX); PG8_BAR; PG8_SCHED; } while (0)
#define PG8_TRIP_VARS() \
            const bool last = (t == nt - 2); \
            const unsigned a1 = PG8_AOFF(t + 1); \
            const unsigned a2 = last ? nA : PG8_AOFF(t + 2), b2 = last ? nB : cB + (unsigned)(t + 2) * kstep; \
            const unsigned a3 = a2 + kstep, b3 = b2 + kstep; \
            const bool f1 = MIXED && (t + 1 >= NTB), f2 = MIXED && !last && (t + 2 >= NTB); (void)f1; (void)f2;
        if constexpr (MIXED) {
#pragma unroll 1
            for (int t = 0; t < NTB; t += 2) { PG8_TRIP_VARS() PG8_TRIP(false); }
            { const int l2 = lane_volatile(); E.mid(acc, cur, wr, wc, l2 & 15, l2 >> 4); }
#pragma unroll 1
            for (int t = NTB; t < nt; t += 2) { PG8_TRIP_VARS() PG8_TRIP(true); }
        } else {
#pragma unroll 1
            for (int t = 0; t < nt; t += 2) {
                if constexpr (DUALA) { if (t == MIDT) { const int l2 = lane_volatile(); E.mid(acc, cur, wr, wc, l2 & 15, l2 >> 4); } }
                PG8_TRIP_VARS() PG8_TRIP(F8);
            }
        }
#undef PG8_TRIP_VARS
#undef PG8_TRIP
        if constexpr (ALIGN_EPI) { if (wr == 0) PG8_BAR; }
        { const int l2 = lane_volatile(); E(acc, cur, ui, wr, wc, l2 & 15, l2 >> 4); }
        if (!has_next) break;
#pragma unroll
        for (int a = 0; a < 2; ++a)
#pragma unroll
            for (int b = 0; b < 2; ++b)
#pragma unroll
                for (int m = 0; m < 4; ++m)
#pragma unroll
                    for (int n = 0; n < 2; ++n) { acc[a][b][m][n] = zero4_asm(); }
        cur = nxt; cA = nA; cA2 = nA2; cB = nB; ++ui;
        if constexpr (ALIGN_EPI) { if (wr == 1) PG8_BAR; }
    }
    PG8_WAIT_V(0);
    if constexpr (!ALIGN_EPI) { if (wr == 0) PG8_BAR; }
    PG8_BAR;
#undef PG8_SA
#undef PG8_SB
#undef PG8_DMA
#undef PG8_STAGE_B
#undef PG8_STAGE_A
#undef PG8_LDA
#undef PG8_LDB
#undef PG8_MMA
#undef PG8_F8OP
#undef PG8_WAIT_V
#undef PG8_WAIT_L
#undef PG8_BAR
#undef PG8_SCHED
#undef PG8_GLOAD
#undef PG8_AOFF
}
}

constexpr size_t MiB = 1u << 20;
constexpr size_t WS_CTL = 0, CTL_ZERO_BYTES = 1 * MiB;
constexpr size_t WS_CS = 1 * MiB;
constexpr size_t WS_WTS = 3 * MiB;
constexpr size_t WS_LIST = 672 * MiB;
constexpr size_t WS_WIN = 12 * MiB;
constexpr size_t WS_WC = 37 * MiB, WS_WA = 41 * MiB, WS_WO = 45 * MiB;
constexpr size_t WS_RW = 49 * MiB;
constexpr size_t WS_RSTD = 50 * MiB;
constexpr size_t WS_W13 = 64 * MiB;
constexpr size_t WS_W2 = 320 * MiB;
constexpr size_t WS_N = 448 * MiB;
constexpr size_t WS_U = 512 * MiB, WS_CC = 576 * MiB, WS_Q = 640 * MiB;
constexpr size_t WS_K = 704 * MiB, WS_VT = 712 * MiB;
constexpr size_t WS_G = 720 * MiB;
constexpr size_t WS_H = 848 * MiB;
constexpr size_t WS_H8 = WS_H + 64 * MiB;
constexpr size_t WS_O8 = WS_H8 + 32 * MiB;
constexpr size_t WS_WIN8 = 24 * MiB;
constexpr size_t WS_N8 = 976 * MiB;
constexpr size_t WS_END = 1008 * MiB;
constexpr int CW_BAR = 4096;
constexpr int CW_CNT = 65536;

constexpr int RING_OFF = 0, RING_BYTES = 131072;
constexpr int LDSCTL_OFF = RING_BYTES, MISC_OFF = LDSCTL_OFF + 320;
constexpr int WSLOT_OFF = LDSCTL_OFF + 512;
constexpr int TAB_OFF = RING_BYTES + 1024;
constexpr int TOK_OFF = TAB_OFF + 1024;
constexpr int WT_OFF = TOK_OFF + MAX_UNITS * 1024;
constexpr int TOKA_OFF = WT_OFF + MAX_UNITS * 1024;
constexpr int WTA_OFF = TOKA_OFF + MAX_UNITS * 1024;
constexpr int LDS_BYTES = 159744;
static_assert(WTA_OFF + MAX_UNITS * 1024 <= LDS_BYTES, "LDS map");

#define GAS __attribute__((address_space(1)))
#define LAS __attribute__((address_space(3)))
typedef unsigned short bf16;
typedef unsigned v4u __attribute__((ext_vector_type(4)));
typedef unsigned v2u __attribute__((ext_vector_type(2)));
typedef float f32x4 __attribute__((ext_vector_type(4)));
typedef float f32x16 __attribute__((ext_vector_type(16)));
typedef short bf16x8 __attribute__((ext_vector_type(8)));
typedef GAS unsigned gu32;
#define RLX_AGENT __ATOMIC_RELAXED, __HIP_MEMORY_SCOPE_AGENT
#define LDS_WAIT() asm volatile("s_waitcnt lgkmcnt(0)" ::: "memory")
#define VM_WAIT() asm volatile("s_waitcnt vmcnt(0)" ::: "memory")
__device__ __forceinline__ unsigned pk2(float lo, float hi) { return pg8::cvt_pk_bf16(lo, hi); }
__device__ __forceinline__ float bflo(unsigned w) { return __uint_as_float(w << 16); }
__device__ __forceinline__ float bfhi(unsigned w) { return __uint_as_float(w & 0xffff0000u); }

#define XB_TMO      128
#define XB_XCNT(j)  (256  + 64 * (j))
#define XB_XSUB(j)  (1280 + 64 * (j))
#define XB_XGEN(j)  (2304 + 64 * (j))
#define XB_TOP      3328
#define XB_TOPGEN   3392
#define XCD_BAR_WORDS 3456
#define XB_SPIN_CAP (1u << 22)
__device__ __forceinline__ unsigned* xb_at(unsigned* p) { unsigned long long z; asm volatile("v_mov_b64 %0, 0" : "=v"(z)); return (unsigned*)((char*)p + z); }
__device__ __forceinline__ unsigned xb_ld(unsigned* p)              { return __hip_atomic_load(xb_at(p), __ATOMIC_RELAXED, __HIP_MEMORY_SCOPE_AGENT); }
__device__ __forceinline__ unsigned xb_add(unsigned* p, unsigned v) { return __hip_atomic_fetch_add(xb_at(p), v, __ATOMIC_RELAXED, __HIP_MEMORY_SCOPE_AGENT); }
__device__ __forceinline__ unsigned xb_xcc_id() { return (unsigned)__builtin_amdgcn_s_getreg((3 << 11) | 20) & 0xFu; }
#define XB_SPIN(cond, bar) do { unsigned _sp = 0; while (cond) { __builtin_amdgcn_s_sleep(1); \
    if ((++_sp & 255u) == 0u) { if (xb_ld(&(bar)[XB_TMO])) break; if (_sp > XB_SPIN_CAP) { (void)xb_add(&(bar)[XB_TMO], 1u); break; } } } } while (0)
struct XcdBarrier { unsigned* bar; unsigned x; volatile LAS unsigned* st; };
__device__ __forceinline__ XcdBarrier xcd_barrier_post(unsigned* bar, volatile LAS unsigned* st, int tid) {
    XcdBarrier b; b.bar = bar; b.x = xb_xcc_id(); b.st = st;
    if (tid == 0) (void)xb_add(&bar[XB_XCNT(b.x)], 1u);
    return b;
}
__device__ __forceinline__ void xcd_barrier_complete(unsigned* bar, unsigned x, unsigned& nloc, unsigned& nx) {
    const unsigned G = gridDim.x * gridDim.y * gridDim.z;
    unsigned sum, cnt, mine, sp = 0u;
    for (;;) {
        sum = 0u; cnt = 0u; mine = 0u;
#pragma unroll
        for (unsigned j = 0; j < 16; ++j) { const unsigned c = xb_ld(&bar[XB_XCNT(j)]); sum += c; cnt += (c > 0u) ? 1u : 0u; mine = (j == x) ? c : mine; }
        if (sum == G) break;
        __builtin_amdgcn_s_sleep(1);
        if ((++sp & 255u) == 0u) { if (xb_ld(&bar[XB_TMO])) break; if (sp > XB_SPIN_CAP) { (void)xb_add(&bar[XB_TMO], 1u); break; } }
    }
    nloc = mine > 0u ? mine : 1u; nx = cnt > 0u ? cnt : 1u;
}
__device__ __forceinline__ void xcd_barrier(const XcdBarrier& b, int tid) {
    asm volatile("s_waitcnt vmcnt(0)" ::: "memory");
    __syncthreads();
    if (tid == 0) {
        unsigned* bar = b.bar;
        __builtin_amdgcn_s_waitcnt(0);
        unsigned nloc = b.st[0], nx = b.st[1];
        if (nloc == 0u) { xcd_barrier_complete(bar, b.x, nloc, nx); b.st[0] = nloc; b.st[1] = nx; }
        const unsigned old = xb_add(&bar[XB_XSUB(b.x)], 1u);
        const unsigned gen = old / nloc;
        if (old + 1u == (gen + 1u) * nloc) {
            __builtin_amdgcn_fence(__ATOMIC_RELEASE, "agent");
            asm volatile("s_waitcnt vmcnt(0)" ::: "memory");
            const unsigned og = xb_add(&bar[XB_TOP], 1u);
            const unsigned tg = og / nx;
            if (og + 1u == (tg + 1u) * nx) xb_add(&bar[XB_TOPGEN], 1u);
            else XB_SPIN(xb_ld(&bar[XB_TOPGEN]) == tg, bar);
            __builtin_amdgcn_fence(__ATOMIC_ACQUIRE, "agent");
            xb_add(&bar[XB_XGEN(b.x)], 1u);
            asm volatile("s_waitcnt vmcnt(0)" ::: "memory");
        } else {
            XB_SPIN(xb_ld(&bar[XB_XGEN(b.x)]) == gen, bar);
            __builtin_amdgcn_fence(__ATOMIC_ACQUIRE, "agent");
            asm volatile("s_waitcnt vmcnt(0)" ::: "memory");
        }
    }
    __syncthreads();
}

struct Args { const void* in[19]; float* out; unsigned char* ws; int ph_lo, ph_hi; };

__device__ __forceinline__ float xshfl(float v, int k, int lane) { return __int_as_float(__builtin_amdgcn_ds_bpermute((lane ^ k) << 2, __float_as_int(v))); }
__device__ __forceinline__ float wave_sum(float v, int lane) {
#pragma unroll
    for (int o = 1; o < 64; o <<= 1) v += xshfl(v, o, lane);
    return v;
}

struct CvtItem { const float* src; bf16* dst; unsigned char* dst8; const float* kscale; float oscale; int N, K, k0, perm; };
__device__ __forceinline__ void cvt_load(const CvtItem& d, f32x4 (&v)[16], int lane) {
    const int kk = lane >> 4, n4 = lane & 15;
#pragma unroll
    for (int i = 0; i < 16; ++i) v[i] = __builtin_nontemporal_load((const GAS f32x4*)(d.src + (size_t)(4 * i + kk) * d.N + 4 * n4));
}
__device__ __forceinline__ void cvt_finish(const CvtItem& d, f32x4 (&v)[16], LAS float* scr, int lane) {
    const int kk = lane >> 4, n4 = lane & 15;
    if (d.kscale) {
#pragma unroll
        for (int i = 0; i < 16; ++i) v[i] = v[i] * d.kscale[d.k0 + 4 * i + kk]; }
#pragma unroll
    for (int i = 0; i < 16; ++i) { const int k = 4 * i + kk; *(LAS f32x4*)(scr + k * 64 + 4 * (n4 ^ ((k >> 3) & 7))) = v[i]; }
    LDS_WAIT(); asm volatile("" ::: "memory");
    const int c = lane & 7, nlo = lane >> 3;
#pragma unroll
    for (int jj = 0; jj < 2; ++jj) { float x[4][8];
#pragma unroll
        for (int j = 0; j < 4; ++j) { const int pos = nlo + 8 * (4 * jj + j); int col = pos; if (d.perm && pos < 16) col = (pos >> 1) + 8 * (pos & 1);
            const LAS float* s = scr + (8 * c) * 64 + (col ^ (4 * c));
#pragma unroll
            for (int i = 0; i < 8; ++i) x[j][i] = s[i * 64]; }
#pragma unroll
        for (int j = 0; j < 4; ++j) { const int pos = nlo + 8 * (4 * jj + j);
            if (d.dst8) { const float sc = d.oscale;
                const v2u o8 = pg8::pack8_f8((f32x4){x[j][0] * sc, x[j][1] * sc, x[j][2] * sc, x[j][3] * sc}, (f32x4){x[j][4] * sc, x[j][5] * sc, x[j][6] * sc, x[j][7] * sc});
                __builtin_nontemporal_store(o8, (GAS v2u*)(d.dst8 + (size_t)pos * d.K + 8 * c)); }
            else {
            v4u o; o.x = pg8::cvt_pk_bf16_c(x[j][0], x[j][1]); o.y = pg8::cvt_pk_bf16_c(x[j][2], x[j][3]); o.z = pg8::cvt_pk_bf16_c(x[j][4], x[j][5]); o.w = pg8::cvt_pk_bf16_c(x[j][6], x[j][7]);
            __builtin_nontemporal_store(o, (GAS v4u*)(d.dst + (size_t)pos * d.K + 8 * c)); } } }
    LDS_WAIT(); asm volatile("" ::: "memory");
}
__device__ __forceinline__ int inproj_srccol(int np) {
    if (np < 2048) { const int t = np >> 8, r = np & 255; return (r < 128) ? (t * 128 + r) : (2048 + t * 128 + (r - 128)); }
    return 1024 + (np - 2048);
}
__device__ __forceinline__ int inproj8_srccol0(int n8) { return 3072 + n8; }

__device__ __forceinline__ void sincos_d(double ang, float& s, float& c) {
    const double k = __builtin_rint(ang * 0.6366197723675814);
    double r = __builtin_fma(-k, 1.5707963267948966, ang); r = __builtin_fma(-k, 6.123233995736766e-17, r);
    const double r2 = r * r;
    double sp = -1.0 / 1307674368000.0; sp = sp * r2 + 1.0 / 6227020800.0; sp = sp * r2 - 1.0 / 39916800.0; sp = sp * r2 + 1.0 / 362880.0; sp = sp * r2 - 1.0 / 5040.0; sp = sp * r2 + 1.0 / 120.0; sp = sp * r2 - 1.0 / 6.0; sp = sp * r2 * r + r;
    double cp = 1.0 / 20922789888000.0; cp = cp * r2 - 1.0 / 87178291200.0; cp = cp * r2 + 1.0 / 479001600.0; cp = cp * r2 - 1.0 / 3628800.0; cp = cp * r2 + 1.0 / 40320.0; cp = cp * r2 - 1.0 / 720.0; cp = cp * r2 + 1.0 / 24.0; cp = cp * r2 - 0.5; cp = cp * r2 + 1.0;
    const int q = (int)((long long)k & 3);
    const double ss = (q == 0) ? sp : (q == 1) ? cp : (q == 2) ? -sp : -cp;
    const double cc = (q == 0) ? cp : (q == 1) ? -sp : (q == 2) ? -cp : sp;
    s = (float)ss; c = (float)cc;
}

struct RowIn { f32x4 v[4]; v2u h[4]; unsigned a[4], b[4]; };
template <int MODE> __device__ __forceinline__ void norm_load(RowIn& r, int lane, const float* xin, const bf16* hin, const unsigned char* s0, const unsigned char* s1) {
    if (MODE == 0) { const GAS f32x4* xr = (const GAS f32x4*)xin + lane;
#pragma unroll
        for (int j = 0; j < 4; ++j) r.v[j] = xr[64 * j]; }
    else { const GAS v2u* hr = (const GAS v2u*)hin + lane; const GAS unsigned* a = (const GAS unsigned*)s0 + lane; const GAS unsigned* b = (const GAS unsigned*)s1 + lane;
#pragma unroll
        for (int j = 0; j < 4; ++j) { r.h[j] = hr[64 * j]; r.a[j] = a[64 * j]; r.b[j] = b[64 * j]; } }
}
template <int MODE> __device__ __forceinline__ void norm_finish(RowIn& r, int lane, bf16* hsum, const f32x4 (&gg)[4], bf16* nout, unsigned char* n8out, float* fout) {
    f32x4 v[4]; float ss = 0.f;
    if (MODE == 0) {
#pragma unroll
        for (int j = 0; j < 4; ++j) v[j] = r.v[j]; }
    else {
#pragma unroll
        for (int j = 0; j < 4; ++j) { const v2u h = r.h[j]; typedef float f2 __attribute__((ext_vector_type(2)));
            const f2 x0 = __builtin_amdgcn_cvt_pk_f32_fp8((int)r.a[j], false), x1 = __builtin_amdgcn_cvt_pk_f32_fp8((int)r.a[j], true);
            const f2 y0 = __builtin_amdgcn_cvt_pk_f32_fp8((int)r.b[j], false), y1 = __builtin_amdgcn_cvt_pk_f32_fp8((int)r.b[j], true);
            v[j] = (f32x4){bflo(h.x), bfhi(h.x), bflo(h.y), bfhi(h.y)} + ((f32x4){x0.x, x0.y, x1.x, x1.y} + (f32x4){y0.x, y0.y, y1.x, y1.y}) * (1.0f / pg8::SLAB_SCALE); } }
    if (MODE == 1) { GAS v2u* o = (GAS v2u*)hsum + lane;
#pragma unroll
        for (int j = 0; j < 4; ++j) { v2u w; w.x = pk2(v[j].x, v[j].y); w.y = pk2(v[j].z, v[j].w); o[64 * j] = w; v[j] = (f32x4){bflo(w.x), bfhi(w.x), bflo(w.y), bfhi(w.y)}; } }
#pragma unroll
    for (int j = 0; j < 4; ++j) ss += (v[j].x * v[j].x + v[j].y * v[j].y) + (v[j].z * v[j].z + v[j].w * v[j].w);
    const float rstd = 1.f / sqrtf(wave_sum(ss, lane) * (1.f / D) + RMS_EPS);
#pragma unroll
    for (int j = 0; j < 4; ++j) v[j] = v[j] * rstd * gg[j];
    if (MODE != 2) { GAS v2u* o = (GAS v2u*)nout + lane; GAS int* o8 = (GAS int*)n8out + lane;
#pragma unroll
        for (int j = 0; j < 4; ++j) { v2u w; w.x = pk2(v[j].x, v[j].y); w.y = pk2(v[j].z, v[j].w); o[64 * j] = w;
            int w8 = __builtin_bit_cast(int, v[j].x); w8 = __builtin_amdgcn_cvt_pk_fp8_f32(v[j].x, v[j].y, w8, false); w8 = __builtin_amdgcn_cvt_pk_fp8_f32(v[j].z, v[j].w, w8, true); o8[64 * j] = w8; } }
    else { GAS f32x4* o = (GAS f32x4*)fout + lane;
#pragma unroll
        for (int j = 0; j < 4; ++j) o[64 * j] = v[j]; }
}
#define NORM_LOAD2(ra_, rb_, m_) do { const int ma_ = (m_), mb_ = ma_ + NGW; \
        norm_load<MODE>(ra_, lane, MODE == 0 ? xin + (size_t)ma_ * D : nullptr, MODE ? h16 + (size_t)ma_ * D : nullptr, MODE ? slab + (size_t)(2 * ma_) * D : nullptr, MODE ? slab + (size_t)(2 * ma_ + 1) * D : nullptr); \
        if (mb_ < T) norm_load<MODE>(rb_, lane, MODE == 0 ? xin + (size_t)mb_ * D : nullptr, MODE ? h16 + (size_t)mb_ * D : nullptr, MODE ? slab + (size_t)(2 * mb_) * D : nullptr, MODE ? slab + (size_t)(2 * mb_ + 1) * D : nullptr); } while (0)
#define NORM_FIN2(ra_, rb_, m_) do { const int ma_ = (m_), mb_ = ma_ + NGW; \
        norm_finish<MODE>(ra_, lane, MODE == 1 ? h16 + (size_t)ma_ * D : nullptr, gg, MODE != 2 ? nout + (size_t)ma_ * D : nullptr, MODE != 2 ? n8out + (size_t)ma_ * D : nullptr, MODE == 2 ? fout + (size_t)ma_ * D : nullptr); \
        if (mb_ < T) norm_finish<MODE>(rb_, lane, MODE == 1 ? h16 + (size_t)mb_ * D : nullptr, gg, MODE != 2 ? nout + (size_t)mb_ * D : nullptr, MODE != 2 ? n8out + (size_t)mb_ * D : nullptr, MODE == 2 ? fout + (size_t)mb_ * D : nullptr); } while (0)
template <int MODE> __device__ __forceinline__ void norm_rows(int lane, int gw, int NGW, const float* xin, bf16* h16, const unsigned char* slab, const float* g, bf16* nout, unsigned char* n8out, float* fout) {
    int m = gw; if (m >= T) return;
    f32x4 gg[4];
    { const GAS f32x4* gr = (const GAS f32x4*)g + lane;
#pragma unroll
      for (int j = 0; j < 4; ++j) gg[j] = gr[64 * j]; }
    RowIn a0, a1, b0, b1;
    NORM_LOAD2(a0, a1, m);
    for (;;) {
        const int mn = m + 2 * NGW; const bool hasn = mn < T;
        if (hasn) NORM_LOAD2(b0, b1, mn);
        NORM_FIN2(a0, a1, m);
        if (!hasn) break;
        m = mn + 2 * NGW; const bool has2 = m < T;
        if (has2) NORM_LOAD2(a0, a1, m);
        NORM_FIN2(b0, b1, mn);
        if (!has2) break;
    }
}
#undef NORM_LOAD2
#undef NORM_FIN2

constexpr int RT_BROW = 528, RT_BHALF = 80 * RT_BROW, RT_LG_OFF = 86016, RT_LGROW = 81;
__device__ __forceinline__ void router_block(LAS unsigned char* lds, int tid, int r0, const bf16* H, const bf16* WR, const float* bg, const float* broute,
                                             unsigned* cnt, int* lists, float* wts, float* rstd_out) {
    const int lane = tid & 63, wave = __builtin_amdgcn_readfirstlane(tid >> 6), fr = lane & 15, fq = lane >> 4;
    const bf16* hrow = H + (size_t)(r0 + wave * 16 + fr) * D + 8 * fq;
    LAS unsigned* cntB = (LAS unsigned*)(lds + TAB_OFF); LAS unsigned* baseB = cntB + 64;
    if (tid < 64) cntB[tid] = 0u;
    f32x4 acc[5];
#pragma unroll
    for (int nb = 0; nb < 5; ++nb) acc[nb] = (f32x4){0.f, 0.f, 0.f, 0.f};
    float ssq = 0.f;
    v4u av[8]; v4u bw[10];
#define RT_LOADB(c_) do { _Pragma("unroll") for (int i = 0; i < 10; ++i) { const int q = tid + 512 * i; const int hl = q / 2560, rem = q % 2560, n = rem >> 5, ch = rem & 31; \
            bw[i] = *(const GAS v4u*)(WR + ((size_t)hl * 80 + n) * D + (c_) * 256 + ch * 8); } } while (0)
#pragma unroll
    for (int ks = 0; ks < 8; ++ks) av[ks] = *(const GAS v4u*)(hrow + ks * 32);
    RT_LOADB(0);
#pragma unroll
    for (int c = 0; c < 4; ++c) {
        __syncthreads();
#pragma unroll
        for (int i = 0; i < 10; ++i) { const int q = tid + 512 * i; const int hl = q / 2560, rem = q % 2560, n = rem >> 5, ch = rem & 31;
            *(LAS v4u*)(lds + hl * RT_BHALF + n * RT_BROW + ch * 16) = bw[i]; }
        __syncthreads();
        if (c < 3) RT_LOADB(c + 1);
#pragma unroll
        for (int ks = 0; ks < 8; ++ks) {
            const v4u a = av[ks];
            if (c < 3) av[ks] = *(const GAS v4u*)(hrow + (c + 1) * 256 + ks * 32);
            { const float x0 = bflo(a.x), x1 = bfhi(a.x), x2 = bflo(a.y), x3 = bfhi(a.y), x4 = bflo(a.z), x5 = bfhi(a.z), x6 = bflo(a.w), x7 = bfhi(a.w);
              ssq += (x0 * x0 + x1 * x1) + (x2 * x2 + x3 * x3) + (x4 * x4 + x5 * x5) + (x6 * x6 + x7 * x7); }
            const bf16x8 ah = __builtin_bit_cast(bf16x8, a);
#pragma unroll
            for (int nb = 0; nb < 5; ++nb) {
                const bf16x8 bh = *(const LAS bf16x8*)(lds + (nb * 16 + fr) * RT_BROW + ks * 64 + fq * 16);
                const bf16x8 bl = *(const LAS bf16x8*)(lds + RT_BHALF + (nb * 16 + fr) * RT_BROW + ks * 64 + fq * 16);
                acc[nb] = __builtin_amdgcn_mfma_f32_16x16x32_bf16(ah, bh, acc[nb], 0, 0, 0);
                acc[nb] = __builtin_amdgcn_mfma_f32_16x16x32_bf16(ah, bl, acc[nb], 0, 0, 0);
            }
        }
    }
#undef RT_LOADB
    ssq += xshfl(ssq, 16, lane); ssq += xshfl(ssq, 32, lane);
    const float rs = 1.f / sqrtf(ssq * (1.f / D) + RMS_EPS);
    LAS float* LG = (LAS float*)(lds + RT_LG_OFF) + wave * 16 * RT_LGROW;
#pragma unroll
    for (int nb = 0; nb < 5; ++nb)
#pragma unroll
        for (int i = 0; i < 4; ++i) LG[(4 * fq + i) * RT_LGROW + nb * 16 + fr] = acc[nb][i];
    LDS_WAIT(); asm volatile("" ::: "memory");
    int ea = 0, eb = 0; unsigned ra = 0u, rb = 0u; float wa = 0.f, wb = 0.f;
    if (lane < 16) {
        const LAS float* lr = LG + lane * RT_LGROW;
        unsigned long long z_; asm volatile("v_mov_b64 %0, 0" : "=v"(z_)); const float* bgz = (const float*)((const char*)bg + z_);
        float lg[8];
#pragma unroll
        for (int e = 0; e < 8; ++e) lg[e] = lr[e] * rs + bgz[e];
        int gi = 0; float gm = lg[0];
#pragma unroll
        for (int e = 1; e < 8; ++e) if (lg[e] > gm) { gm = lg[e]; gi = e; }
        float gs = 0.f;
#pragma unroll
        for (int e = 0; e < 8; ++e) gs += __expf(lg[e] - gm);
        const float pgroup = 1.f / gs;
        float le[8];
#pragma unroll
        for (int e = 0; e < 8; ++e) le[e] = lr[8 + gi * 8 + e] * rs + broute[gi * 8 + e];
        int i1 = 0; float m1 = le[0];
#pragma unroll
        for (int e = 1; e < 8; ++e) if (le[e] > m1) { m1 = le[e]; i1 = e; }
        int i2 = -1; float m2 = -INFINITY;
#pragma unroll
        for (int e = 0; e < 8; ++e) if (e != i1 && le[e] > m2) { m2 = le[e]; i2 = e; }
        const float e2 = __expf(m2 - m1); const float inv = 1.f / (1.f + e2);
        ea = gi * 8 + i1; eb = gi * 8 + i2; wa = pgroup * inv; wb = pgroup * e2 * inv;
        ra = __hip_atomic_fetch_add(cntB + ea, 1u, __ATOMIC_RELAXED, __HIP_MEMORY_SCOPE_WORKGROUP); rb = __hip_atomic_fetch_add(cntB + eb, 1u, __ATOMIC_RELAXED, __HIP_MEMORY_SCOPE_WORKGROUP);
    }
    __syncthreads();
    if (tid < 64) { const unsigned n = cntB[tid]; unsigned b0 = 0u; if (n) b0 = atomicAdd(cnt + tid * 16, n); baseB[tid] = b0; }
    __syncthreads();
    if (lane < 16) {
        const int t = r0 + wave * 16 + lane;
        const unsigned sa = baseB[ea] + ra, sb = baseB[eb] + rb;
        const unsigned rsb = __float_as_uint(rs);
        ((GAS v4u*)lists)[(size_t)ea * LIST_CAP + sa] = (v4u){(unsigned)(2 * t), __float_as_uint(wa), rsb, 0u};
        ((GAS v4u*)lists)[(size_t)eb * LIST_CAP + sb] = (v4u){(unsigned)(2 * t + 1), __float_as_uint(wb), rsb, 0u};
        (void)wts; (void)rstd_out;
    }
}

constexpr int KROW = 144, VROW = 400, KIMG = 192 * KROW, VIMG = 64 * VROW;
#define ATT_LOADKV(u_) do { const int kh_ = (u_) & 1, c_ = ((u_) >> 1) & 127, b_ = (u_) >> 8; \
        _Pragma("unroll") for (int i = 0; i < 3; ++i) { const int q = tid + 512 * i; const int row = q >> 3, ch = q & 7; int cj = c_ - 2 + (row >> 6); cj = cj < 0 ? 0 : cj; \
            kreg[i] = *(const GAS v4u*)(Kb + ((size_t)(b_ * SEQ + cj * 64 + (row & 63))) * 128 + kh_ * 64 + ch * 8); } \
        _Pragma("unroll") for (int i = 0; i < 3; ++i) { const int q = tid + 512 * i; const int d = q / 24, rem = q % 24, j = rem >> 3, ch = rem & 7; int cj = c_ - 2 + j; cj = cj < 0 ? 0 : cj; \
            vreg[i] = *(const GAS v4u*)(VT + ((size_t)((b_ * 2 + kh_) * 64 + d)) * SEQ + cj * 64 + ch * 8); } } while (0)
__device__ __forceinline__ void attn_phase(LAS unsigned char* lds, int tid, int vcu, int G, const unsigned char* Q, unsigned char* O, const bf16* Kb, const bf16* VT, const float* sinks) {
    const int lane = tid & 63, wid = __builtin_amdgcn_readfirstlane(tid >> 6), r32 = lane & 31, hi = lane >> 5;
    constexpr int NUNITS = BATCH * (SEQ / CHUNK) * NKV;
    const int sig = (r32 & 19) | ((r32 & 4) << 1) | ((r32 & 8) >> 1);
    const LAS unsigned char* kbase = lds + sig * KROW + hi * 16;
    const LAS unsigned char* vbase = lds + KIMG + r32 * VROW + hi * 16;
    v4u kreg[3], vreg[3];
    const float sink0 = sinks[wid] * LOG2E, sink1 = sinks[8 + wid] * LOG2E;
#define ATT_UNIT(k_) ((G == 256) ? ((k_) < 4 ? (((vcu >> 5) >> 1) << 8) | ((64 * ((vcu >> 5) & 1) + ((127 - ((vcu & 31) + 32 * (k_))) >> 1)) << 1) | ((127 - ((vcu & 31) + 32 * (k_))) & 1) : NUNITS) : vcu + (k_) * G)
    if (ATT_UNIT(0) < NUNITS) ATT_LOADKV(ATT_UNIT(0));
    for (int ku = 0; ; ++ku) {
        const int u = ATT_UNIT(ku); if (u >= NUNITS) break;
        const int kh = u & 1, c = (u >> 1) & 127, b = u >> 8;
        __syncthreads();
#pragma unroll
        for (int i = 0; i < 3; ++i) { const int q = tid + 512 * i; const int row = q >> 3, ch = q & 7; *(LAS v4u*)(lds + row * KROW + ch * 16) = kreg[i]; }
#pragma unroll
        for (int i = 0; i < 3; ++i) { const int q = tid + 512 * i; const int d = q / 24, rem = q % 24, j = rem >> 3, ch = rem & 7; *(LAS v4u*)(lds + KIMG + d * VROW + j * 128 + ch * 16) = vreg[i]; }
        __syncthreads();
        const int head = kh * 8 + wid;
        const size_t tok0 = (size_t)b * SEQ + c * 64 + r32;
        bf16x8 qr[2][4];
        v2u qraw[2][4];
#pragma unroll
        for (int qt = 0; qt < 2; ++qt)
#pragma unroll
            for (int d0 = 0; d0 < 4; ++d0) qraw[qt][d0] = *(const GAS v2u*)(Q + (tok0 + qt * 32) * D + head * 64 + d0 * 16 + hi * 8);
#pragma unroll
        for (int qt = 0; qt < 2; ++qt)
#pragma unroll
            for (int d0 = 0; d0 < 4; ++d0) { const v2u q8 = qraw[qt][d0];
                typedef float f2 __attribute__((ext_vector_type(2))); constexpr float QI = 1.0f / pg8::Q8_SCALE;
                const f2 a0 = __builtin_amdgcn_cvt_pk_f32_fp8((int)q8.x, false), a1 = __builtin_amdgcn_cvt_pk_f32_fp8((int)q8.x, true), b0 = __builtin_amdgcn_cvt_pk_f32_fp8((int)q8.y, false), b1 = __builtin_amdgcn_cvt_pk_f32_fp8((int)q8.y, true);
                v4u w; w.x = pk2(a0.x * QI, a0.y * QI); w.y = pk2(a1.x * QI, a1.y * QI); w.z = pk2(b0.x * QI, b0.y * QI); w.w = pk2(b1.x * QI, b1.y * QI);
                qr[qt][d0] = __builtin_bit_cast(bf16x8, w); }
        { const int un = ATT_UNIT(ku + 1); if (un < NUNITS) ATT_LOADKV(un); }
        const float sinkl2 = kh ? sink1 : sink0;
#pragma unroll
        for (int qt = 0; qt < 2; ++qt) {
            unsigned char* op = O + (tok0 + qt * 32) * D + head * 64;
            f32x16 s[6];
#pragma unroll
            for (int t = 0; t < 6; ++t) {
                s[t] = (f32x16){0.f, 0.f, 0.f, 0.f, 0.f, 0.f, 0.f, 0.f, 0.f, 0.f, 0.f, 0.f, 0.f, 0.f, 0.f, 0.f};
#pragma unroll
                for (int d0 = 0; d0 < 4; ++d0) { const bf16x8 kf = *(const LAS bf16x8*)(kbase + t * 32 * KROW + d0 * 32);
                    s[t] = __builtin_amdgcn_mfma_f32_32x32x16_bf16(kf, qr[qt][d0], s[t], 0, 0, 0); }
            }
            if (c < 2) {
                asm volatile("" ::: "memory");
#pragma unroll
                for (int t = 0; t < 6; ++t) if (c - 2 + (t >> 1) < 0) {
#pragma unroll
                    for (int r = 0; r < 16; ++r) s[t][r] = -INFINITY; } }
            float m = sinkl2;
#pragma unroll
            for (int t = 0; t < 6; ++t)
#pragma unroll
                for (int r = 0; r < 16; ++r) m = fmaxf(m, s[t][r]);
            m = fmaxf(m, xshfl(m, 32, lane));
            float l = 0.f;
#pragma unroll
            for (int t = 0; t < 6; ++t)
#pragma unroll
                for (int r = 0; r < 16; ++r) { s[t][r] = __builtin_amdgcn_exp2f(s[t][r] - m); l += s[t][r]; }
            l += xshfl(l, 32, lane);
            l += __builtin_amdgcn_exp2f(sinkl2 - m);
            const float rl = 1.f / l;
            f32x16 o[2];
#pragma unroll
            for (int dt = 0; dt < 2; ++dt) o[dt] = (f32x16){0.f, 0.f, 0.f, 0.f, 0.f, 0.f, 0.f, 0.f, 0.f, 0.f, 0.f, 0.f, 0.f, 0.f, 0.f, 0.f};
#pragma unroll
            for (int t = 0; t < 6; ++t)
#pragma unroll
                for (int ks = 0; ks < 2; ++ks) {
                    v4u pw; pw.x = pk2(s[t][8 * ks + 0], s[t][8 * ks + 1]); pw.y = pk2(s[t][8 * ks + 2], s[t][8 * ks + 3]); pw.z = pk2(s[t][8 * ks + 4], s[t][8 * ks + 5]); pw.w = pk2(s[t][8 * ks + 6], s[t][8 * ks + 7]);
                    const bf16x8 pf = __builtin_bit_cast(bf16x8, pw);
#pragma unroll
                    for (int dt = 0; dt < 2; ++dt) { const bf16x8 vf = *(const LAS bf16x8*)(vbase + dt * 32 * VROW + (t * 32 + ks * 16) * 2);
                        o[dt] = __builtin_amdgcn_mfma_f32_32x32x16_bf16(vf, pf, o[dt], 0, 0, 0); }
                }
#pragma unroll
            for (int dt = 0; dt < 2; ++dt)
#pragma unroll
                for (int g = 0; g < 4; ++g) { const float o0_ = o[dt][4 * g] * rl; int w = __builtin_bit_cast(int, o0_);
                    w = __builtin_amdgcn_cvt_pk_fp8_f32(o0_, o[dt][4 * g + 1] * rl, w, false); w = __builtin_amdgcn_cvt_pk_fp8_f32(o[dt][4 * g + 2] * rl, o[dt][4 * g + 3] * rl, w, true);
                    *(GAS int*)(op + dt * 32 + 8 * g + 4 * hi) = w; }
        }
    }
    __syncthreads();
}
#undef ATT_LOADKV
#undef ATT_UNIT

__device__ __forceinline__ void conv_item(int tid, int item, const bf16* U, const bf16* CCb, const float* cw, bf16* AO) {
    const int cg = tid & 127, rq = tid >> 7; const int t0 = item * 64 + rq * 16; const int s0 = t0 & (SEQ - 1); const int ch = cg * 8;
#define CV_UNPACK8(dst_, x_) do { dst_[0] = bflo((x_).x); dst_[1] = bfhi((x_).x); dst_[2] = bflo((x_).y); dst_[3] = bfhi((x_).y); dst_[4] = bflo((x_).z); dst_[5] = bfhi((x_).z); dst_[6] = bflo((x_).w); dst_[7] = bfhi((x_).w); } while (0)
    const auto rU = __builtin_amdgcn_make_buffer_rsrc((void*)U, 0, 0xffffffff, 0x00020000);
    const auto rC = __builtin_amdgcn_make_buffer_rsrc((void*)CCb, 0, 0xffffffff, 0x00020000);
    const int oc = 2 * (t0 * D + ch);
    v4u xu[16], x2 = {0u, 0u, 0u, 0u}, x1 = {0u, 0u, 0u, 0u}; v4u xc[16];
    if (s0 >= 2) x2 = __builtin_bit_cast(v4u, __builtin_amdgcn_raw_buffer_load_b128(rU, oc - 4 * D, 0, 0));
    if (s0 >= 1) x1 = __builtin_bit_cast(v4u, __builtin_amdgcn_raw_buffer_load_b128(rU, oc - 2 * D, 0, 0));
#pragma unroll
    for (int r = 0; r < 16; ++r) { xu[r] = __builtin_bit_cast(v4u, __builtin_amdgcn_raw_buffer_load_b128(rU, oc, r * D * 2, 0)); xc[r] = __builtin_bit_cast(v4u, __builtin_amdgcn_raw_buffer_load_b128(rC, oc, r * D * 2, 0)); }
    float w[3][8];
#pragma unroll
    for (int j = 0; j < 3; ++j) { const f32x4 a = *(const GAS f32x4*)(cw + j * D + ch), b = *(const GAS f32x4*)(cw + j * D + ch + 4);
        w[j][0] = a.x; w[j][1] = a.y; w[j][2] = a.z; w[j][3] = a.w; w[j][4] = b.x; w[j][5] = b.y; w[j][6] = b.z; w[j][7] = b.w; }
    float p2[8], p1[8];
    CV_UNPACK8(p2, x2); CV_UNPACK8(p1, x1);
#pragma unroll
    for (int r = 0; r < 16; ++r) {
        float u0[8]; CV_UNPACK8(u0, xu[r]);
        float c0[8]; CV_UNPACK8(c0, xc[r]);
        float y[8];
#pragma unroll
        for (int k = 0; k < 8; ++k) { y[k] = c0[k] * (w[0][k] * p2[k] + w[1][k] * p1[k] + w[2][k] * u0[k]); p2[k] = p1[k]; p1[k] = u0[k]; }
        v4u ov; ov.x = pk2(y[0], y[1]); ov.y = pk2(y[2], y[3]); ov.z = pk2(y[4], y[5]); ov.w = pk2(y[6], y[7]);
        *(GAS v4u*)(AO + (size_t)(t0 + r) * D + ch) = ov;
    }
#undef CV_UNPACK8
}

constexpr int NWAVES = 8;
constexpr int PH_PER_LAYER = 9;
constexpr int N_PHASES = 1 + DEPTH * PH_PER_LAYER + 1;

__device__ __forceinline__ int my_lane_volatile() { int l; asm volatile("v_mbcnt_lo_u32_b32 %0, -1, 0\n\tv_mbcnt_hi_u32_b32 %0, -1, %0" : "=v"(l)); return l; }
typedef __attribute__((address_space(4))) const Args* KArgs;
constexpr int CI_IN = 16 * 100, CI_SQ = 16 * 16, CI_13 = 16 * 16 * 64, CI_2 = 8 * 16 * 64, CI_SMALL = CI_IN + 3 * CI_SQ, CI_EXP = CI_13 + CI_2;
__device__ __forceinline__ CvtItem cvt_decode(KArgs A, unsigned char* ws, int kind, int it) {
    CvtItem d; d.kscale = nullptr; d.perm = 0; d.dst8 = nullptr; d.dst = nullptr; d.oscale = 1.f;
    const int per_layer = kind == 0 ? CI_SMALL : CI_EXP; const int l = it / per_layer; int r = it % per_layer;
    if (kind == 0) {
        if (r < CI_IN) { const int kb = r / 100, grp = r % 100; d.N = IN_COLS; d.K = D; d.k0 = kb * 64;
            if (grp < 48) { const int n0 = grp * 64;
                d.src = (const float*)A->in[3] + (size_t)l * D * IN_COLS + (size_t)d.k0 * IN_COLS + inproj_srccol(n0); d.dst = (bf16*)(ws + WS_WIN) + (size_t)l * 3072 * D + (size_t)n0 * D + d.k0; }
            else { const int n8 = (grp - 48) * 64; d.perm = (n8 < 1152) ? 1 : 0; d.oscale = pg8::WIN8_SCALE;
                d.src = (const float*)A->in[3] + (size_t)l * D * IN_COLS + (size_t)d.k0 * IN_COLS + inproj8_srccol0(n8); d.dst8 = (unsigned char*)(ws + WS_WIN8) + (size_t)l * 3328 * D + (size_t)n8 * D + d.k0; } }
        else { r -= CI_IN; const int w = r / CI_SQ; const int rr = r % CI_SQ; const int kb = rr / 16, n0 = (rr % 16) * 64; d.N = D; d.k0 = kb * 64;
            d.src = (const float*)A->in[7 + w] + (size_t)l * D * D + (size_t)d.k0 * D + n0;
            if (w == 0) { d.K = 1536; d.dst = (bf16*)(ws + WS_WC + (size_t)l * D * 3072) + (size_t)n0 * 1536 + d.k0; }
            else if (w == 1) { d.K = 3072; d.oscale = pg8::WA_SCALE; d.dst8 = (unsigned char*)(ws + WS_WC + (size_t)l * D * 3072) + (size_t)n0 * 3072 + 2048 + d.k0; }
            else { d.K = D; d.dst = (bf16*)(ws + WS_WO) + (size_t)l * D * D + (size_t)n0 * D + d.k0; } }
    } else {
        if (r < CI_13) { const int e = r / 256, rr = r % 256; const int kb = rr / 16, n0 = (rr % 16) * 64; const int which = (n0 >> 7) & 1; const int sc0 = (n0 >> 8) * 128 + (n0 & 127);
            d.N = FF; d.K = D; d.k0 = kb * 64; d.kscale = (const float*)A->in[10] + l * D;
            d.src = (const float*)A->in[15 + which] + ((size_t)(l * NEXP + e)) * D * FF + (size_t)d.k0 * FF + sc0; d.oscale = pg8::W13_SCALE;
            d.dst8 = (unsigned char*)(ws + WS_W13) + ((size_t)(l * NEXP + e)) * 1024 * D + (size_t)n0 * D + d.k0; }
        else { r -= CI_13; const int e = r / 128, rr = r % 128; const int kb = rr / 16, n0 = (rr % 16) * 64; d.N = D; d.K = FF; d.k0 = kb * 64;
            d.src = (const float*)A->in[17] + ((size_t)(l * NEXP + e)) * FF * D + (size_t)d.k0 * D + n0; d.oscale = pg8::W2_SCALE;
            d.dst8 = (unsigned char*)(ws + WS_W2) + ((size_t)(l * NEXP + e)) * D * FF + (size_t)n0 * FF + d.k0; }
    }
    return d;
}
__device__ __forceinline__ void convert_items(KArgs A, unsigned char* ws, LAS unsigned char* lds, int kind, int lane, int wave, int gw, int NGW, int end) {
    LAS float* scr = (LAS float*)(lds + RING_OFF + wave * 16384);
    int it0 = gw; if (it0 >= end) return;
    f32x4 va[16], vb[16];
    CvtItem d0 = cvt_decode(A, ws, kind, it0), d1 = d0; cvt_load(d0, va, lane);
    for (;;) {
        const int it1 = it0 + NGW; const bool has1 = it1 < end;
        if (has1) { d1 = cvt_decode(A, ws, kind, it1); cvt_load(d1, vb, lane); }
        cvt_finish(d0, va, scr, lane);
        if (!has1) break;
        it0 = it1 + NGW; const bool has0 = it0 < end;
        if (has0) { d0 = cvt_decode(A, ws, kind, it0); cvt_load(d0, va, lane); }
        cvt_finish(d1, vb, scr, lane);
        if (!has0) break;
    }
}
__device__ __forceinline__ KArgs kargs() { KArgs p = (KArgs)__builtin_amdgcn_kernarg_segment_ptr(); asm volatile("" : "+s"(p)); return p; }

template <int L> struct LayerTag { static constexpr int value = L; };
__global__ void __launch_bounds__(NWAVES * 64, 2) fwd_kernel(Args args_unused) {
    extern __shared__ __attribute__((aligned(16))) unsigned char lds_raw[];
    LAS unsigned char* lds = (LAS unsigned char*)lds_raw;
#define HW_SLOT() ((int)__builtin_amdgcn_s_getreg((5 << 11) | 4) & 63)
#define MY_TID() (((volatile LAS int*)(lds + WSLOT_OFF))[HW_SLOT()] * 64 + my_lane_volatile())
    {   const int tid0 = threadIdx.x;
        { unsigned z0_; asm volatile("v_mov_b32 %0, 0" : "=v"(z0_));
          for (int u = tid0; u < (TAB_OFF - LDSCTL_OFF) / 4; u += NWAVES * 64) ((LAS unsigned*)(lds + LDSCTL_OFF))[u] = z0_; }
        __syncthreads();
        if ((tid0 & 63) == 0) ((volatile LAS int*)(lds + WSLOT_OFF))[HW_SLOT()] = tid0 >> 6;
        __syncthreads();
        if (!MK_PER_PHASE) { KArgs A = kargs(); (void)xcd_barrier_post((unsigned*)((gu32*)(A->ws + WS_CTL) + CW_BAR), (volatile LAS unsigned*)(lds + MISC_OFF) + 8, tid0); }
    }
#define PH_LOCALS \
    KArgs A = kargs(); unsigned char* ws = A->ws; (void)ws; \
    int tid_ = MY_TID(); asm volatile("" : "+v"(tid_)); const int tid = tid_, lane = tid & 63, wave = __builtin_amdgcn_readfirstlane(tid >> 6); (void)lane; (void)wave; \
    const int G = gridDim.x; const int bx = blockIdx.x; const int vcu = (G % 8 == 0) ? (bx % 8) * (G / 8) + bx / 8 : bx; (void)vcu; \
    const int gw = vcu * NWAVES + wave, NGW = G * NWAVES; (void)gw; (void)NGW;
#define IN(k) (kargs()->ph_lo <= (k) && (k) < kargs()->ph_hi)
#define SEAM(k) do { if (!MK_PER_PHASE && IN(k) && IN((k) + 1)) { KArgs A_ = kargs(); XcdBarrier bar_; bar_.bar = (unsigned*)((gu32*)(A_->ws + WS_CTL) + CW_BAR); bar_.x = xb_xcc_id(); \
        bar_.st = (volatile LAS unsigned*)(lds + MISC_OFF) + 8; xcd_barrier(bar_, MY_TID()); } } while (0)

    if (IN(0)) {
        PH_LOCALS
        convert_items(A, ws, lds, 0, lane, wave, gw, NGW, DEPTH * CI_SMALL);
        { const int* positions = (const int*)A->in[1]; float* CS = (float*)(ws + WS_CS);
          for (int idx = vcu * 512 + tid; idx < T * 8; idx += G * 512) { const int t = idx >> 3, i = idx & 7;
              double iv = 1.0;
              iv = (i == 1) ? 0.19392274474868576 : iv; iv = (i == 2) ? 0.03760603093086393 : iv; iv = (i == 3) ? 0.0072926647372171085 : iv; iv = (i == 4) ? 0.0014142135623730952 : iv;
              iv = (i == 5) ? 0.0002742481756762073 : iv; iv = (i == 6) ? 5.318295896944988e-05 : iv; iv = (i == 7) ? 1.0313385377212458e-05 : iv;
              float sn, cn; sincos_d((double)positions[t] * iv, sn, cn); CS[(size_t)t * 16 + i] = cn; CS[(size_t)t * 16 + 8 + i] = sn; } }
        { bf16* WR = (bf16*)(ws + WS_RW);
          for (int idx = vcu * 512 + tid; idx < DEPTH * 80 * D; idx += G * 512) { const int l = idx / (80 * D), rem = idx % (80 * D), n = rem / D, k = rem % D;
              float w = 0.f;
              if (n < 8) w = ((const float*)A->in[11])[((size_t)l * D + k) * 8 + n];
              else if (n < 72) { const int g = (n - 8) >> 3, e = (n - 8) & 7; w = ((const float*)A->in[13])[(((size_t)l * 8 + g) * D + k) * 8 + e]; }
              w *= ((const float*)A->in[10])[l * D + k];
              const unsigned hi = pg8::cvt_pk_bf16_c(w, 0.f) & 0xffffu; const float rest = w - __uint_as_float(hi << 16); const unsigned lo = pg8::cvt_pk_bf16_c(rest, 0.f) & 0xffffu;
              WR[((size_t)(l * 2 + 0) * 80 + n) * D + k] = (bf16)hi; WR[((size_t)(l * 2 + 1) * 80 + n) * D + k] = (bf16)lo; } }
        { const float* x = (const float*)A->in[0]; bf16* NB = (bf16*)(ws + WS_N); const float* g1 = (const float*)A->in[2];
          norm_rows<0>(lane, gw, NGW, x, nullptr, nullptr, g1, NB, (unsigned char*)(ws + WS_N8), nullptr); }
    }
    SEAM(0);

    auto layer_body = [&](auto lc_) { constexpr int l = decltype(lc_)::value;
        const int pb = 1 + l * PH_PER_LAYER;
        if (IN(pb + 0)) {
            PH_LOCALS
            bf16* HB = (bf16*)(ws + WS_H); const unsigned char* SLAB = (const unsigned char*)(ws + WS_U); bf16* NB = (bf16*)(ws + WS_N); const float* g1 = (const float*)A->in[2] + l * D;
            if (l > 0) norm_rows<1>(lane, gw, NGW, nullptr, HB, SLAB, g1, NB, (unsigned char*)(ws + WS_N8), nullptr);
        }
        if (l > 0) SEAM(pb + 0);
        if (IN(pb + 1)) {
            PH_LOCALS
            pg8::Gemm g{(bf16*)(ws + WS_N), (bf16*)(ws + WS_WIN) + (size_t)l * 3072 * D, nullptr}; pg8::StaticOrder<T, 3072, 4> S; S.init(G, bx);
            pg8::EpiInProj<0> E{(bf16*)(ws + WS_U), (bf16*)(ws + WS_CC), (bf16*)(ws + WS_Q), (bf16*)(ws + WS_K), (bf16*)(ws + WS_VT), (bf16*)(ws + WS_G), (const float*)A->in[4] + l * 2048, (const float*)(ws + WS_CS), 1.0f};
            const bool few = (G == 256) && (bx >= 128); const int cfirst = (G == 256) ? (few ? 23552 + (bx - 128) * 8 + wave : bx * 8 + wave) : gw;
            const int cstride = (G == 256) ? 1024 : NGW; const int cend = (G == 256 && !few) ? 23552 : DEPTH * CI_EXP;
            if (l == 0 && (vcu & 1) == 0) { convert_items(A, ws, lds, 1, lane, wave, cfirst, cstride, cend); __syncthreads(); }
            pg8::gemm_phase<pg8::EpiInProj<0>, pg8::StaticOrder<T, 3072, 4>, true, true, false, D>(lds + RING_OFF, tid, g, S, E, nullptr);
            { pg8::Gemm g8{(const pg8::bf16_t*)(ws + WS_N8), (const pg8::bf16_t*)(ws + WS_WIN8 + (size_t)l * 3328 * D), nullptr}; pg8::StaticOrder<T, 3328, 2> S8; S8.init(G, bx);
              pg8::EpiInProj<1> E8{E.U, E.CC, E.Q, E.Kb, E.VT, E.G, E.bgate, E.cs, 1.0f / pg8::WIN8_SCALE};
              pg8::gemm_phase<pg8::EpiInProj<1>, pg8::StaticOrder<T, 3328, 2>, true, true, false, D, false, true>(lds + RING_OFF, tid, g8, S8, E8, nullptr); }
        }
        if (IN(pb + 1) && l == 0) {
            PH_LOCALS
            if ((vcu & 1) == 1) {
                const bool few = (G == 256) && (bx >= 128); const int cfirst = (G == 256) ? (few ? 23552 + (bx - 128) * 8 + wave : bx * 8 + wave) : gw;
                const int cstride = (G == 256) ? 1024 : NGW; const int cend = (G == 256 && !few) ? 23552 : DEPTH * CI_EXP;
                convert_items(A, ws, lds, 1, lane, wave, cfirst, cstride, cend); __syncthreads(); }
        }
        SEAM(pb + 1);
        if (IN(pb + 2)) {
            PH_LOCALS
            const unsigned char* QB = (const unsigned char*)(ws + WS_Q); const bf16* KB = (const bf16*)(ws + WS_K); const bf16* VTB = (const bf16*)(ws + WS_VT);
            unsigned char* OB = (unsigned char*)(ws + WS_O8);
            const float* sinks = (const float*)A->in[6] + l * 16;
            attn_phase(lds, tid, vcu, G, QB, OB, KB, VTB, sinks);
            const float* cw = (const float*)A->in[5] + l * 3 * D;
            if (G == 256) { for (int k = 0; k < 2; ++k) conv_item(tid, (vcu >> 5) * 64 + 63 - ((vcu & 31) + 32 * k), (const bf16*)(ws + WS_U), (const bf16*)(ws + WS_CC), cw, (bf16*)(ws + WS_N)); }
            else for (int it = vcu; it < T / 64; it += G) conv_item(tid, it, (const bf16*)(ws + WS_U), (const bf16*)(ws + WS_CC), cw, (bf16*)(ws + WS_N));
        }
        SEAM(pb + 2);
        if (IN(pb + 3)) {
            PH_LOCALS
            pg8::Gemm g{(bf16*)(ws + WS_N), (const pg8::bf16_t*)(ws + WS_WC + (size_t)l * D * 3072), (const pg8::bf16_t*)(ws + WS_O8)}; pg8::StaticOrder<T, D> S; S.init(G, bx);
            pg8::EpiGate2 E{(const unsigned char*)(ws + WS_G), (bf16*)(ws + WS_CC)};
            pg8::gemm_phase<pg8::EpiGate2, pg8::StaticOrder<T, D>, true, true, false, 2 * D, true, false, true>(lds + RING_OFF, tid, g, S, E, nullptr);
        }
        SEAM(pb + 4);
        if (IN(pb + 5)) {
            PH_LOCALS
            pg8::Gemm g{(bf16*)(ws + WS_CC), (bf16*)(ws + WS_WO) + (size_t)l * D * D, nullptr}; pg8::StaticOrder<T, D, pg8::WGM, true> S; S.init(G, bx);
            pg8::EpiResid E{(l == 0) ? (const float*)A->in[0] : nullptr, (const bf16*)(ws + WS_H), (bf16*)(ws + WS_H), (unsigned char*)(ws + WS_H8)};
            pg8::gemm_phase<pg8::EpiResid, pg8::StaticOrder<T, D, pg8::WGM, true>, true, true, false, D>(lds + RING_OFF, tid, g, S, E, nullptr);
        }
        SEAM(pb + 5);
        if (IN(pb + 6)) {
            PH_LOCALS
            unsigned* cnt = (unsigned*)((gu32*)(ws + WS_CTL) + CW_CNT) + l * 64 * 16;
            const float* bg = (const float*)A->in[12] + l * 8; const float* brt = (const float*)A->in[14] + l * 64;
            const bf16* HB = (const bf16*)(ws + WS_H); int* LISTS = (int*)(ws + WS_LIST); float* WTS = (float*)(ws + WS_WTS);
            const bf16* WR = (const bf16*)(ws + WS_RW) + (size_t)l * 2 * 80 * D;
            for (int rb = vcu; rb < T / 128; rb += G) router_block(lds, tid, rb * 128, HB, WR, bg, brt, cnt, LISTS, WTS, (float*)(ws + WS_RSTD));
        }
        SEAM(pb + 6);
#define MOE_PTRS \
        LAS int* tstart = (LAS int*)(lds + TAB_OFF); LAS int* cntL = (LAS int*)(lds + TAB_OFF + 512); \
        LAS int* tokT = (LAS int*)(lds + TOK_OFF); LAS float* wtT = (LAS float*)(lds + WT_OFF); LAS int* tokA = (LAS int*)(lds + TOKA_OFF); LAS float* wtA = (LAS float*)(lds + WTA_OFF); \
        (void)cntL; (void)tokT; (void)wtT; (void)tokA; (void)wtA;
#define MOE_ORDER \
        pg8::MoeOrder S; S.NT4 = __builtin_amdgcn_readfirstlane(tstart[64] * 4); S.G = G; S.c = vcu; S.uexp = (LAS int*)(lds + TAB_OFF + 768);
#define MOE_BUILD \
        { unsigned* cnt = (unsigned*)((gu32*)(ws + WS_CTL) + CW_CNT) + l * 64 * 16; const int* LISTS = (const int*)(ws + WS_LIST); const float* WTS = (const float*)(ws + WS_WTS); const float* RSTD = (const float*)(ws + WS_RSTD); \
          if (tid < 64) { const int c_ = (int)__hip_atomic_load(cnt + tid * 16, RLX_AGENT); cntL[tid] = c_; const int v_ = (c_ + 255) >> 8; int inc_ = v_; \
              _Pragma("unroll") for (int d_ = 1; d_ < 64; d_ *= 2) { const int o_ = __builtin_amdgcn_ds_bpermute(((tid - d_) & 63) * 4, inc_); if (tid >= d_) inc_ += o_; } \
              tstart[tid] = inc_ - v_; if (tid == 63) tstart[64] = inc_; } \
          __syncthreads(); \
          if (tid < MAX_UNITS) { const int mt_ = (tid * G + vcu) >> 2; int e_ = 0; for (int k_ = 1; k_ < 64; ++k_) e_ += (tstart[k_] <= mt_) ? 1 : 0; ((LAS int*)(lds + TAB_OFF + 768))[tid] = e_; } \
          __syncthreads(); \
          MOE_ORDER \
          v4u entv[MAX_UNITS]; \
          _Pragma("unroll") for (int i = 0; i < MAX_UNITS; ++i) { entv[i] = (v4u){0xffffffffu, 0u, 0u, 0u}; pg8::Unit u; if (S.next(i, u) && tid < 256) { const int e = u.pn >> 2; const int idx = (u.pm - tstart[e]) * 256 + tid; \
              if (idx < cntL[e]) entv[i] = ((const GAS v4u*)LISTS)[(size_t)e * LIST_CAP + idx]; } } \
          _Pragma("unroll") for (int i = 0; i < MAX_UNITS; ++i) { if (i * G + vcu < S.NT4 && tid < 256) { const int aid = (int)entv[i].x; const bool valid = aid >= 0; \
              tokT[i * 256 + tid] = valid ? (aid >> 1) : 0; wtT[i * 256 + tid] = valid ? __uint_as_float(entv[i].z) : 0.f; tokA[i * 256 + tid] = aid; wtA[i * 256 + tid] = valid ? __uint_as_float(entv[i].y) : 0.f; } } \
          __syncthreads(); }
        if (IN(pb + 7)) {
            PH_LOCALS
            MOE_PTRS
            MOE_BUILD
            MOE_ORDER
            pg8::Gemm g{(const pg8::bf16_t*)(ws + WS_H8), (const pg8::bf16_t*)(ws + WS_W13 + (size_t)l * NEXP * 1024 * D), nullptr}; pg8::EpiFfn1 E{(unsigned char*)(ws + WS_G), wtT};
            pg8::gemm_phase<pg8::EpiFfn1, pg8::MoeOrder, true, true, true, D, false, true>(lds + RING_OFF, tid, g, S, E, tokT);
        }
        SEAM(pb + 7);
        if (IN(pb + 8)) {
            PH_LOCALS
            MOE_PTRS
            if (MK_PER_PHASE) MOE_BUILD
            MOE_ORDER
            pg8::Gemm g{(const pg8::bf16_t*)(ws + WS_G), (const pg8::bf16_t*)(ws + WS_W2 + (size_t)l * NEXP * D * FF), nullptr}; pg8::EpiFfn2 E{(unsigned char*)(ws + WS_U), tokA, wtA};
            pg8::gemm_phase<pg8::EpiFfn2, pg8::MoeOrder, true, true, false, FF, false, true>(lds + RING_OFF, tid, g, S, E, nullptr);
        }
        SEAM(pb + 8);
#undef MOE_PTRS
#undef MOE_ORDER
#undef MOE_BUILD
    };
    layer_body(LayerTag<0>{}); layer_body(LayerTag<1>{});
    static_assert(DEPTH == 2, "two layers");
    if (IN(N_PHASES - 1)) {
        PH_LOCALS
        bf16* HB = (bf16*)(ws + WS_H); const unsigned char* SLAB = (const unsigned char*)(ws + WS_U);
        norm_rows<2>(lane, gw, NGW, nullptr, HB, SLAB, (const float*)A->in[18], nullptr, nullptr, A->out);
    }
#undef IN
#undef SEAM
#undef PH_LOCALS
#undef MY_TID
#undef HW_SLOT
}

extern "C" void kernel_launch(void* const* d_in, const int* in_sizes, int n_in, void* d_out, int out_size, void* d_ws, size_t ws_size, hipStream_t stream) {
    static int grid = 0;
    if (grid == 0) {
        if (n_in != 19 || out_size != T * D || ws_size < WS_END) { fprintf(stderr, "kernel_launch: unexpected sizes n_in %d out %d ws %zu\n", n_in, out_size, ws_size); grid = -1; return; }
        int dev = 0, cus = 0;
        if (hipGetDevice(&dev) != hipSuccess || hipDeviceGetAttribute(&cus, hipDeviceAttributeMultiprocessorCount, dev) != hipSuccess) { grid = -1; return; }
        if (hipFuncSetAttribute((const void*)fwd_kernel, hipFuncAttributeMaxDynamicSharedMemorySize, LDS_BYTES) != hipSuccess) { fprintf(stderr, "kernel_launch: hipFuncSetAttribute failed\n"); grid = -1; return; }
        (void)hipGetLastError();
        grid = cus;
    }
    if (grid < 0) return;
    if (hipMemsetAsync((char*)d_ws + WS_CTL, 0, CTL_ZERO_BYTES, stream) != hipSuccess) return;
    Args a{};
    for (int i = 0; i < 19; ++i) a.in[i] = d_in[i];
    a.out = (float*)d_out; a.ws = (unsigned char*)d_ws;
#if MK_PER_PHASE
    for (int p = 0; p < N_PHASES; ++p) { a.ph_lo = p; a.ph_hi = p + 1; hipLaunchKernelGGL(fwd_kernel, dim3(grid), dim3(NWAVES * 64), LDS_BYTES, stream, a); }

#else
    a.ph_lo = 0; a.ph_hi = N_PHASES;
    hipLaunchKernelGGL(fwd_kernel, dim3(grid), dim3(NWAVES * 64), LDS_BYTES, stream, a);
#endif
}
```
